# Optimizing an MI355X kernel written in HIP

```python
import math
import jax, jax.numpy as jnp
from jax import lax
import numpy as np

D_MODEL = 1024
BATCH = 8
SEQ = 8192
DEPTH = 1

HEAD_DIM = 64
MIX_WIDTH = D_MODEL
A_HEADS = MIX_WIDTH // (2 * HEAD_DIM)
A_KV_HEADS = max(1, A_HEADS // 4)
B_HEADS = MIX_WIDTH // HEAD_DIM - A_HEADS
A_WIDTH = A_HEADS * HEAD_DIM
A_KV_WIDTH = A_KV_HEADS * HEAD_DIM
B_WIDTH = B_HEADS * HEAD_DIM
IN_WIDTH = A_WIDTH + 2 * A_KV_WIDTH + 3 * B_WIDTH
IN_SPLITS = (A_WIDTH, A_WIDTH + A_KV_WIDTH, A_WIDTH + 2 * A_KV_WIDTH,
             A_WIDTH + 2 * A_KV_WIDTH + B_WIDTH, A_WIDTH + 2 * A_KV_WIDTH + 2 * B_WIDTH)
ROPE_THETA = 10000.0
GRID_W = 64
Q_BLOCK = 128
DILATED_PATTERNS = ((128, 1), (512, 4), (2048, 16))
SUBSEQ_BLOCK = 64
N_GROUPS = 4
EXPERTS_PER_GROUP = 8
N_EXPERTS = N_GROUPS * EXPERTS_PER_GROUP
TOP_K = 2
D_EXPERT = D_MODEL // 2
MOE_BLOCK = 512
EPS = 1e-6
NEG_INF = -1e30

kernel_name = "hymba_axial_gqa_longnet_hmoe_encoder"


def _rms_norm(x, g):
    xf = x.astype(jnp.float32)
    y = xf * lax.rsqrt(jnp.mean(xf * xf, axis=-1, keepdims=True) + EPS)
    return (y * g.astype(jnp.float32)).astype(x.dtype)


def _rope_inv_freq(dim):
    return 1.0 / (ROPE_THETA ** (jnp.arange(0, dim, 2, dtype=jnp.float32) / dim))


def _apply_rotary(x, angles):
    cos, sin = jnp.cos(angles), jnp.sin(angles)
    xf = x.astype(jnp.float32)
    x1, x2 = jnp.split(xf, 2, axis=-1)
    return jnp.concatenate([x1 * cos - x2 * sin, x2 * cos + x1 * sin], axis=-1).astype(x.dtype)


def _axial_angles(seq_len):
    rows = seq_len // GRID_W
    row = jnp.repeat(jnp.arange(rows, dtype=jnp.float32), GRID_W)
    col = jnp.tile(jnp.arange(GRID_W, dtype=jnp.float32), rows)
    f = _rope_inv_freq(HEAD_DIM // 2)
    return jnp.concatenate([row[:, None] * f, col[:, None] * f], axis=-1)


def _linear_angles(seq_len):
    t = jnp.arange(seq_len, dtype=jnp.float32)
    return t[:, None] * _rope_inv_freq(HEAD_DIM)


def _global_axial_gqa(q, k, v, q_norm_g, k_norm_g):
    b, s, _ = q.shape
    grp = A_HEADS // A_KV_HEADS
    q = q.reshape(b, s, A_KV_HEADS, grp, HEAD_DIM).transpose(0, 2, 3, 1, 4)
    k = k.reshape(b, s, A_KV_HEADS, HEAD_DIM).transpose(0, 2, 1, 3)
    v = v.reshape(b, s, A_KV_HEADS, HEAD_DIM).transpose(0, 2, 1, 3)
    ang = _axial_angles(s)
    q = _apply_rotary(_rms_norm(q, q_norm_g), ang)
    k = _apply_rotary(_rms_norm(k, k_norm_g), ang)
    nq = s // Q_BLOCK
    qb = jnp.moveaxis(q.reshape(b, A_KV_HEADS, grp, nq, Q_BLOCK, HEAD_DIM), 3, 0)
    scale = HEAD_DIM ** -0.5

    def block(qblk):
        sc = jnp.einsum('bkgqd,bksd->bkgqs', qblk, k, preferred_element_type=jnp.float32) * scale
        p = jax.nn.softmax(sc, axis=-1).astype(v.dtype)
        return jnp.einsum('bkgqs,bksd->bkgqd', p, v)

    o = lax.map(block, qb)
    o = jnp.moveaxis(o, 0, 3).reshape(b, A_KV_HEADS, grp, s, HEAD_DIM)
    return o.transpose(0, 3, 1, 2, 4).reshape(b, s, A_WIDTH)


def _dilated_window(q, k, v, window, dilation):
    b, h, s, d = q.shape
    r = window // (2 * dilation)
    L = s // dilation

    def to_sub(t):
        return t.reshape(b, h, L, dilation, d).transpose(0, 1, 3, 2, 4)

    qs, ks, vs = to_sub(q), to_sub(k), to_sub(v)
    nblk = -(-L // SUBSEQ_BLOCK)
    lp = nblk * SUBSEQ_BLOCK
    pad4 = ((0, 0), (0, 0), (0, 0))
    qs = jnp.pad(qs, pad4 + ((0, lp - L), (0, 0)))
    kpad = jnp.pad(ks, pad4 + ((r, lp - L + r), (0, 0)))
    vpad = jnp.pad(vs, pad4 + ((r, lp - L + r), (0, 0)))
    kwin = SUBSEQ_BLOCK + 2 * r
    kidx = jnp.arange(nblk)[:, None] * SUBSEQ_BLOCK + jnp.arange(kwin)[None, :]
    kb = jnp.take(kpad, kidx, axis=3)
    vb = jnp.take(vpad, kidx, axis=3)
    qb = qs.reshape(b, h, dilation, nblk, SUBSEQ_BLOCK, d)
    sc = jnp.einsum('bhrnqd,bhrnkd->bhrnqk', qb, kb, preferred_element_type=jnp.float32) * (d ** -0.5)
    qpos = jnp.arange(lp).reshape(nblk, SUBSEQ_BLOCK)
    kpos = kidx - r
    mask = (jnp.abs(qpos[:, :, None] - kpos[:, None, :]) <= r) & ((kpos >= 0) & (kpos < L))[:, None, :]
    sc = jnp.where(mask, sc, NEG_INF)
    m = jnp.max(sc, axis=-1, keepdims=True)
    p = jnp.exp(sc - m)
    den = jnp.sum(p, axis=-1, keepdims=True)
    o = jnp.einsum('bhrnqk,bhrnkd->bhrnqd', p.astype(vb.dtype), vb,
                   preferred_element_type=jnp.float32) / den
    lse = (m + jnp.log(den))[..., 0]
    o = o.astype(v.dtype).reshape(b, h, dilation, lp, d)[:, :, :, :L]
    o = o.transpose(0, 1, 3, 2, 4).reshape(b, h, s, d)
    lse = lse.reshape(b, h, dilation, lp)[:, :, :, :L].transpose(0, 1, 3, 2).reshape(b, h, s)
    return o, lse


def _longnet_mixture(q, k, v):
    b, s, _ = q.shape
    q = q.reshape(b, s, B_HEADS, HEAD_DIM).transpose(0, 2, 1, 3)
    k = k.reshape(b, s, B_HEADS, HEAD_DIM).transpose(0, 2, 1, 3)
    v = v.reshape(b, s, B_HEADS, HEAD_DIM).transpose(0, 2, 1, 3)
    ang = _linear_angles(s)
    q = _apply_rotary(q, ang)
    k = _apply_rotary(k, ang)
    outs, lses = [], []
    for window, dilation in DILATED_PATTERNS:
        o, lse = _dilated_window(q, k, v, window, dilation)
        outs.append(o)
        lses.append(lse)
    w = jax.nn.softmax(jnp.stack(lses, axis=0), axis=0).astype(v.dtype)
    o = jnp.einsum('pbhs,pbhsd->bhsd', w, jnp.stack(outs, axis=0))
    return o.transpose(0, 2, 1, 3).reshape(b, s, B_WIDTH)


def _hierarchical_moe(x, router_group_w, router_group_b, router_expert_w, router_expert_b,
                      w_gate, w_up, w_down):
    b, s, dm = x.shape
    n = b * s
    xt = x.reshape(n, dm)
    g_logits = (xt @ router_group_w).astype(jnp.float32) + router_group_b.astype(jnp.float32)
    g_prob = jax.nn.softmax(g_logits, axis=-1)
    g_top_p, g_top = lax.top_k(g_prob, 1)
    e_logits = (xt @ router_expert_w).astype(jnp.float32) + router_expert_b.astype(jnp.float32)
    e_logits = e_logits.reshape(n, N_GROUPS, EXPERTS_PER_GROUP)
    e_in_group = jnp.take_along_axis(e_logits, g_top[:, :, None], axis=1)[:, 0]
    e_top_logit, e_top = lax.top_k(e_in_group, TOP_K)
    gates = g_top_p * jax.nn.softmax(e_top_logit, axis=-1)
    expert_id = g_top * EXPERTS_PER_GROUP + e_top

    nk = n * TOP_K
    flat_e = expert_id.reshape(nk).astype(jnp.int32)
    flat_tok = jnp.arange(nk, dtype=jnp.int32) // TOP_K
    flat_gate = gates.reshape(nk)
    order = jnp.argsort(flat_e)
    se = flat_e[order]
    counts = jnp.bincount(flat_e, length=N_EXPERTS)
    start = jnp.cumsum(counts) - counts
    padded = (counts + MOE_BLOCK - 1) // MOE_BLOCK * MOE_BLOCK
    pend = jnp.cumsum(padded)
    pstart = pend - padded
    dest = pstart[se] + (jnp.arange(nk, dtype=jnp.int32) - start[se])
    n_blocks = -(-nk // MOE_BLOCK) + N_EXPERTS
    rows = n_blocks * MOE_BLOCK
    row_tok = jnp.zeros((rows,), jnp.int32).at[dest].set(flat_tok[order])
    row_gate = jnp.zeros((rows,), x.dtype).at[dest].set(flat_gate[order].astype(x.dtype))
    block_e = jnp.minimum(jnp.searchsorted(pend, jnp.arange(n_blocks) * MOE_BLOCK, side='right'),
                          N_EXPERTS - 1).astype(jnp.int32)

    def expert_block(args):
        e, tok = args
        xb = xt[tok]
        hdn = jax.nn.silu(xb @ w_gate[e]) * (xb @ w_up[e])
        return hdn @ w_down[e]

    yb = lax.map(expert_block, (block_e, row_tok.reshape(n_blocks, MOE_BLOCK)))
    y = jnp.zeros((n, dm), x.dtype).at[row_tok].add(yb.reshape(rows, dm) * row_gate[:, None])
    return y.reshape(b, s, dm)


def setup_inputs(seed: int = 0) -> dict:
    key = jax.random.key(seed)
    ks = jax.random.split(key, 20)
    f32 = jnp.float32

    def nrm(k, shape, scale):
        return jax.random.normal(k, shape, f32) * scale

    def gain(k, shape):
        return 1.0 + 0.02 * jax.random.normal(k, shape, f32)

    return {
        "x": jax.random.normal(ks[0], (BATCH, SEQ, D_MODEL), f32),
        "norm1_g": gain(ks[1], (DEPTH, D_MODEL)),
        "w_in": nrm(ks[2], (DEPTH, D_MODEL, IN_WIDTH), D_MODEL ** -0.5),
        "q_norm_g": gain(ks[3], (DEPTH, HEAD_DIM)),
        "k_norm_g": gain(ks[4], (DEPTH, HEAD_DIM)),
        "out_norm_a_g": gain(ks[5], (DEPTH, A_WIDTH)),
        "out_norm_b_g": gain(ks[6], (DEPTH, B_WIDTH)),
        "w_out": nrm(ks[7], (DEPTH, MIX_WIDTH, D_MODEL), MIX_WIDTH ** -0.5),
        "norm2_g": gain(ks[8], (DEPTH, D_MODEL)),
        "router_group_w": nrm(ks[9], (DEPTH, D_MODEL, N_GROUPS), D_MODEL ** -0.5),
        "router_group_b": nrm(ks[10], (DEPTH, N_GROUPS), 0.01),
        "router_expert_w": nrm(ks[11], (DEPTH, D_MODEL, N_EXPERTS), D_MODEL ** -0.5),
        "router_expert_b": nrm(ks[12], (DEPTH, N_EXPERTS), 0.01),
        "w_gate": nrm(ks[13], (DEPTH, N_EXPERTS, D_MODEL, D_EXPERT), D_MODEL ** -0.5),
        "w_up": nrm(ks[14], (DEPTH, N_EXPERTS, D_MODEL, D_EXPERT), D_MODEL ** -0.5),
        "w_down": nrm(ks[15], (DEPTH, N_EXPERTS, D_EXPERT, D_MODEL), D_EXPERT ** -0.5),
        "final_norm_g": gain(ks[16], (D_MODEL,)),
    }


def reference(x, norm1_g, w_in, q_norm_g, k_norm_g, out_norm_a_g, out_norm_b_g, w_out,
              norm2_g, router_group_w, router_group_b, router_expert_w, router_expert_b,
              w_gate, w_up, w_down, final_norm_g):
    h = x
    for l in range(DEPTH):
        u = _rms_norm(h, norm1_g[l])
        proj = u @ w_in[l]
        qa, ka, va, qb, kb, vb = jnp.split(proj, IN_SPLITS, axis=-1)
        oa = _rms_norm(_global_axial_gqa(qa, ka, va, q_norm_g[l], k_norm_g[l]), out_norm_a_g[l])
        ob = _rms_norm(_longnet_mixture(qb, kb, vb), out_norm_b_g[l])
        h = h + jnp.concatenate([oa, ob], axis=-1) @ w_out[l]
        h = h + _hierarchical_moe(_rms_norm(h, norm2_g[l]), router_group_w[l], router_group_b[l],
                                  router_expert_w[l], router_expert_b[l],
                                  w_gate[l], w_up[l], w_down[l])
    return _rms_norm(h, final_norm_g)
```

```cpp
#include <hip/hip_runtime.h>
#include <hip/hip_bf16.h>
#include <cstdio>
#include <cstdint>
#include <cmath>

#ifndef PROBE_DUP
#define PROBE_DUP 0
#endif
#ifndef MK_N_LAUNCHES
#define MK_N_LAUNCHES 1
#endif

constexpr int BATCH = 8, SEQ = 8192, DM = 1024, M = BATCH * SEQ;
constexpr int NPROJ = 2304;
constexpr int NEXP = 32, DEXP = 512, LISTCAP = 65536;
constexpr float EPS = 1e-6f;
constexpr float C2 = 0.125f * 1.4426950408889634f;

namespace pg8 {
#define PG8_LAS __attribute__((address_space(3)))
typedef unsigned short bf16_t;
typedef short bf16x8 __attribute__((ext_vector_type(8)));
typedef float f32x4 __attribute__((ext_vector_type(4)));
typedef unsigned u32x4 __attribute__((ext_vector_type(4)));
typedef unsigned u32x2 __attribute__((ext_vector_type(2)));
typedef float f32x2v __attribute__((ext_vector_type(2)));
constexpr int BM = 256, BK = 64, HALF = 128, HTB = HALF * BK * 2, STAGE_BYTES = 8 * HTB, NXCD = 8, WGM = 4;

__host__ __device__ __forceinline__ int lds_byte(int r, int c) { const int st = (r >> 4) * 2 + (c >> 5), rr = r & 15, cc = c & 31, ob = rr * 64 + cc * 2; return st * 1024 + (ob ^ (((ob >> 9) & 1) << 5)); }
__host__ __device__ __forceinline__ void stage_rc(int b, int& R, int& C) { const int st = b / 1024, sb = b % 1024, swz = sb ^ (((sb >> 9) & 1) << 5); R = (st >> 1) * 16 + swz / 64; C = (st & 1) * 32 + (swz % 64) / 2; }
__host__ __device__ __forceinline__ int perm32(int rho) { const int n = rho >> 4, i = rho & 15; return 8 * (i >> 2) + 4 * n + (i & 3); }

struct Unit { int pm, pn, nv, lb; };
struct Gemm { const bf16_t* A; const bf16_t* Bt; int M, N, K; };

struct StaticOrder {
    static constexpr bool GATHER = false, FETCH = false;
    int nM, nN, nwg, G, c;
    __host__ __device__ void init(int M_, int N_, int G_, int c_) { nM = M_ / BM; nN = N_ / BM; nwg = nM * nN; G = G_; c = c_; }
    __host__ __device__ bool next(int i, Unit& u) const {
        const long L = (long)i * G + c; if (L >= nwg) return false;
        int wgid = (int)L; { const int q = nwg / NXCD, r = nwg % NXCD, xcd = wgid % NXCD, off = wgid / NXCD; wgid = (xcd < r ? xcd * (q + 1) : r * (q + 1) + (xcd - r) * q) + off; }
        const int nig = WGM * nN, gid = wgid / nig, fm = gid * WGM, gsz = (nM - fm) < WGM ? (nM - fm) : WGM;
        u.pm = fm + ((wgid % nig) % gsz); u.pn = (wgid % nig) / gsz; u.nv = 256; u.lb = 0; return true;
    }
    __device__ __forceinline__ void fetch(const Unit&, int) const {}
    __device__ __forceinline__ unsigned row_off(const Unit&, int, int) const { return 0u; }
};
template <bool GATHER_> struct MoeOrder {
    int G, c; const PG8_LAS int* tst; const int* list; PG8_LAS int* tokt; const float* rowf; PG8_LAS float* rowt;
    static constexpr bool GATHER = GATHER_, FETCH = true;
    __device__ __forceinline__ bool next(int i, Unit& u) const {
        const int L = i * G + c, T = L >> 2;
        if (T >= tst[32]) return false;
        int e = 0;
#pragma unroll
        for (int j = 0; j < 31; ++j) e += (tst[j + 1] <= T) ? 1 : 0;
        const int rel = T - tst[e], cnt = tst[33 + e];
        int nv = cnt - rel * 256; nv = nv > 256 ? 256 : nv;
        u.pm = __builtin_amdgcn_readfirstlane(T); u.pn = __builtin_amdgcn_readfirstlane(e * 4 + (L & 3)); u.nv = __builtin_amdgcn_readfirstlane(nv); u.lb = __builtin_amdgcn_readfirstlane(e * LISTCAP + rel * 256);
        return true;
    }
    __device__ __forceinline__ void fetch(const Unit& u, int par) const {
        const int tid = threadIdx.x;
        const int w = __builtin_amdgcn_readfirstlane(tid >> 6);
        if (tid < 256) __builtin_amdgcn_global_load_lds((const unsigned*)(list + u.lb + tid), (PG8_LAS unsigned*)(tokt + par * 256 + w * 64), 4, 0, 0);
        else           __builtin_amdgcn_global_load_lds((const unsigned*)(rowf + u.lb + (tid - 256)), (PG8_LAS unsigned*)(rowt + par * 256 + (w - 4) * 64), 4, 0, 0);
    }
    __device__ __forceinline__ unsigned row_off(const Unit& u, int r, int par) const { const int slot = tokt[par * 256 + r]; return (r < u.nv) ? (unsigned)(slot >> 1) * 2048u : 0u; }
};

__device__ __forceinline__ unsigned cvt_pk_bf16(float lo, float hi) { unsigned r; asm volatile("v_cvt_pk_bf16_f32 %0, %1, %2" : "=v"(r) : "v"(lo), "v"(hi)); return r; }

struct EpiBf16 {
    static constexpr bool PERM = true, MID = false;
    bf16_t* O; int ldc;
    __device__ __forceinline__ void operator()(const f32x4 (&acc)[2][2][4][2], const Unit& u, int wr, int wc, int fr, int fq) const {
        const int row0 = u.pm * BM + wr * 64 + fr, col0 = u.pn * BM + wc * 32 + 8 * fq;
#pragma unroll
        for (int ai = 0; ai < 2; ++ai)
#pragma unroll
            for (int m = 0; m < 4; ++m) { bf16_t* rowp = O + (size_t)(row0 + ai * HALF + m * 16) * ldc + col0;
#pragma unroll
                for (int bj = 0; bj < 2; ++bj) { const f32x4 v0 = acc[ai][bj][m][0], v1 = acc[ai][bj][m][1];
                    u32x4 w; w.x = cvt_pk_bf16(v0[0], v0[1]); w.y = cvt_pk_bf16(v0[2], v0[3]); w.z = cvt_pk_bf16(v1[0], v1[1]); w.w = cvt_pk_bf16(v1[2], v1[3]);
                    *(u32x4*)(rowp + bj * HALF) = w; } }
    }
};
__host__ __device__ __forceinline__ int ropemap256(int c) { return 64 * ((c >> 5) & 3) + 16 * (c >> 7) + 4 * ((c >> 3) & 3) + (c & 3) + 32 * ((c >> 2) & 1); }
struct EpiProj {
    static constexpr bool PERM = true, MID = false;
    bf16_t* O; int ldc; const float* cosA; const float* sinA; const float* cosB; const float* sinB; const float* qng; const float* kng; int seqmask; float eps, qscale; unsigned* kmax; int seqshift; unsigned char* kimg; unsigned char* vimg; bf16_t* mbq;
    __device__ __forceinline__ void operator()(const f32x4 (&acc)[2][2][4][2], const Unit& u, int wr, int wc, int fr, int fq) const {
        const int pn = u.pn;
        const bool isqa = pn < 2, iska = (pn == 2) && (wc < 2), isqb = (pn == 3 || pn == 4), iskb = (pn == 5 || pn == 6);
        const bool donorm = isqa || iska, dorope = donorm || isqb || iskb;
        const float sc = (isqa || isqb) ? qscale : 1.0f;
        const float* ct = donorm ? cosA : cosB; const float* st = donorm ? sinA : sinB;
        f32x4 g1[2], g2[2];
#pragma unroll
        for (int bj = 0; bj < 2; ++bj) { g1[bj] = (f32x4){1.f, 1.f, 1.f, 1.f}; g2[bj] = g1[bj]; }
        if (donorm) { const float* gp = isqa ? qng : kng;
#pragma unroll
            for (int bj = 0; bj < 2; ++bj) { g1[bj] = *(const f32x4*)(gp + 16 * bj + 4 * fq); g2[bj] = *(const f32x4*)(gp + 32 + 16 * bj + 4 * fq); } }
        const int row0 = u.pm * BM + wr * 64 + fr;
        const int col16 = (fq & 1) ? (4 * fq - 4) : (32 + 4 * fq);
        float kss_max = 0.f;
#pragma unroll
        for (int am = 0; am < 4; ++am) { const int ai = am >> 1;
            f32x4 tc[4][2], ts[4][2];
            if (dorope) {
#pragma unroll
                for (int m = 2 * (am & 1); m < 2 * (am & 1) + 2; ++m) { const int t = (row0 + ai * HALF + m * 16) & seqmask;
#pragma unroll
                    for (int bj = 0; bj < 2; ++bj) { tc[m][bj] = *(const f32x4*)(ct + t * 32 + 16 * bj + 4 * fq); ts[m][bj] = *(const f32x4*)(st + t * 32 + 16 * bj + 4 * fq); } } }
#pragma unroll
            for (int m = 2 * (am & 1); m < 2 * (am & 1) + 2; ++m) { const int row = row0 + ai * HALF + m * 16;
                f32x4 x1[2], x2[2];
#pragma unroll
                for (int bj = 0; bj < 2; ++bj) { x1[bj] = acc[ai][bj][m][0]; x2[bj] = acc[ai][bj][m][1]; }
                if (donorm) { float ss = 0.f;
#pragma unroll
                    for (int bj = 0; bj < 2; ++bj) ss += (x1[bj][0] * x1[bj][0] + x1[bj][1] * x1[bj][1]) + (x1[bj][2] * x1[bj][2] + x1[bj][3] * x1[bj][3]) + (x2[bj][0] * x2[bj][0] + x2[bj][1] * x2[bj][1]) + (x2[bj][2] * x2[bj][2] + x2[bj][3] * x2[bj][3]);
                    ss += __shfl_xor(ss, 16); ss += __shfl_xor(ss, 32);
                    const float rs = 1.0f / sqrtf(ss * (1.0f / 64.0f) + eps);
#pragma unroll
                    for (int bj = 0; bj < 2; ++bj) { x1[bj] = x1[bj] * rs * g1[bj]; x2[bj] = x2[bj] * rs * g2[bj]; } }
                if (dorope) {
#pragma unroll
                    for (int bj = 0; bj < 2; ++bj) { const f32x4 c = tc[m][bj], sn = ts[m][bj];
                        const f32x4 y1 = (x1[bj] * c - x2[bj] * sn) * sc, y2 = (x2[bj] * c + x1[bj] * sn) * sc; x1[bj] = y1; x2[bj] = y2; } }
                if (iskb) { float ss = 0.f;
#pragma unroll
                    for (int bj = 0; bj < 2; ++bj) ss += (x1[bj][0] * x1[bj][0] + x1[bj][1] * x1[bj][1]) + (x1[bj][2] * x1[bj][2] + x1[bj][3] * x1[bj][3]) + (x2[bj][0] * x2[bj][0] + x2[bj][1] * x2[bj][1]) + (x2[bj][2] * x2[bj][2] + x2[bj][3] * x2[bj][3]);
                    ss += __shfl_xor(ss, 16); ss += __shfl_xor(ss, 32); kss_max = fmaxf(kss_max, ss); }
                const int t = row & seqmask;
                unsigned char* dst;
                int kind;
                if (pn == 2) { const size_t hb = ((size_t)((row >> seqshift) * 2 + (wc & 1)) * 128 + (t >> 6)) * 8192; const int rr = t & 63;
                    if (wc < 2) { dst = kimg + hb + rr * 16; kind = 1; } else { dst = vimg + hb + rr * 64; kind = 2; } }
                else if (pn >= 3) { const int which = (pn - 3) >> 1, hh = ((pn - 3) & 1) * 4 + wc;
                    dst = (unsigned char*)(mbq + ((((size_t)which * 8 + (row >> seqshift)) * 8 + hh) * (size_t)(seqmask + 1) + t) * 64); kind = 0; }
                else { dst = (unsigned char*)(O + (size_t)row * ldc + pn * BM + wc * 64); kind = 0; }
#pragma unroll
                for (int bj = 0; bj < 2; ++bj) { u32x2 lo, hi2; lo.x = cvt_pk_bf16(x1[bj][0], x1[bj][1]); lo.y = cvt_pk_bf16(x1[bj][2], x1[bj][3]); hi2.x = cvt_pk_bf16(x2[bj][0], x2[bj][1]); hi2.y = cvt_pk_bf16(x2[bj][2], x2[bj][3]);
                    const auto rx = __builtin_amdgcn_permlane16_swap(hi2.x, lo.x, false, false), ry = __builtin_amdgcn_permlane16_swap(hi2.y, lo.y, false, false);
                    u32x4 w; w.x = rx[0]; w.y = ry[0]; w.z = rx[1]; w.w = ry[1];
                    const int c = col16 + 16 * bj;
                    unsigned char* p16 = (kind == 0) ? dst + c * 2 : (kind == 1) ? dst + (c >> 3) * 1024 : dst + (c >> 5) * 4096 + (c & 31) * 2;
                    *(u32x4*)p16 = w; } } }
        if (iskb) {
#pragma unroll
            for (int o_ = 1; o_ < 16; o_ <<= 1) kss_max = fmaxf(kss_max, __shfl_xor(kss_max, o_));
            if ((threadIdx.x & 63) == 0) atomicMax(kmax + ((u.pm * BM) >> seqshift) * 8 + (pn - 5) * 4 + wc, __float_as_uint(kss_max)); }
    }
};
struct EpiH {
    static constexpr bool PERM = true, MID = true;
    const float* base; bf16_t* HB; int ldc; const float* ssq; PG8_LAS float* scr; float eps;
    __device__ __forceinline__ void prep(const Unit& u, int par) const {
        const int tid = threadIdx.x;
        if (tid < 256) { const f32x2v q = *(const f32x2v*)(ssq + (size_t)(u.pm * BM + tid) * 2);
            const float rA = 1.0f / sqrtf(q.x * (1.0f / 512.0f) + eps), rB = 1.0f / sqrtf(q.y * (1.0f / 512.0f) + eps);
            scr[par * 512 + tid * 2] = rA / rB; scr[par * 512 + tid * 2 + 1] = rB; }
    }
    __device__ __forceinline__ void mid(f32x4 (&acc)[2][2][4][2], int par, int wr, int fr) const {
#pragma unroll
        for (int ai = 0; ai < 2; ++ai)
#pragma unroll
            for (int m = 0; m < 4; ++m) { const float f = scr[par * 512 + (ai * HALF + wr * 64 + m * 16 + fr) * 2];
#pragma unroll
                for (int bj = 0; bj < 2; ++bj)
#pragma unroll
                    for (int n = 0; n < 2; ++n) acc[ai][bj][m][n] = acc[ai][bj][m][n] * f; }
    }
    __device__ __forceinline__ void operator()(const f32x4 (&acc)[2][2][4][2], const Unit& u, int wr, int wc, int fr, int fq, int par) const {
        const int row0 = u.pm * BM + wr * 64 + fr, col0 = u.pn * BM + wc * 32 + 8 * fq;
#pragma unroll
        for (int ai = 0; ai < 2; ++ai)
#pragma unroll
            for (int m = 0; m < 4; ++m) { const size_t off = (size_t)(row0 + ai * HALF + m * 16) * ldc + col0; const float rB = scr[par * 512 + (ai * HALF + wr * 64 + m * 16 + fr) * 2 + 1];
#pragma unroll
                for (int bj = 0; bj < 2; ++bj) { const f32x4 b0 = *(const f32x4*)(base + off + bj * HALF), b1 = *(const f32x4*)(base + off + bj * HALF + 4);
                    const f32x4 v0 = acc[ai][bj][m][0] * rB + b0, v1 = acc[ai][bj][m][1] * rB + b1;
                    u32x4 w; w.x = cvt_pk_bf16(v0[0], v0[1]); w.y = cvt_pk_bf16(v0[2], v0[3]); w.z = cvt_pk_bf16(v1[0], v1[1]); w.w = cvt_pk_bf16(v1[2], v1[3]);
                    *(u32x4*)(HB + off + bj * HALF) = w; } }
    }
};
__device__ __forceinline__ float silu_f(float x) { return x * __builtin_amdgcn_rcpf(1.0f + __builtin_amdgcn_exp2f(-1.4426950408889634f * x)); }
struct EpiGU {
    static constexpr bool PERM = true, MID = false;
    bf16_t* HDN; const PG8_LAS float* rowt;
    __device__ __forceinline__ void operator()(const f32x4 (&acc)[2][2][4][2], const Unit& u, int wr, int wc, int fr, int fq, int par) const {
        const int pl = u.pn & 3;
#pragma unroll
        for (int ai = 0; ai < 2; ++ai)
#pragma unroll
            for (int m = 0; m < 4; ++m) { const int r = ai * HALF + wr * 64 + m * 16 + fr; const bool ok = r < u.nv;
                const float rs = rowt[par * 256 + r];
                bf16_t* rowp = HDN + (size_t)(u.pm * BM + r) * DEXP + pl * 128 + wc * 32 + 8 * fq;
                const f32x4 g0 = acc[ai][0][m][0] * rs, u0 = acc[ai][0][m][1] * rs, g1 = acc[ai][1][m][0] * rs, u1 = acc[ai][1][m][1] * rs;
                u32x4 w; w.x = cvt_pk_bf16(silu_f(g0[0]) * u0[0], silu_f(g0[1]) * u0[1]); w.y = cvt_pk_bf16(silu_f(g0[2]) * u0[2], silu_f(g0[3]) * u0[3]);
                w.z = cvt_pk_bf16(silu_f(g1[0]) * u1[0], silu_f(g1[1]) * u1[1]); w.w = cvt_pk_bf16(silu_f(g1[2]) * u1[2], silu_f(g1[3]) * u1[3]);
                if (ok) *(u32x4*)rowp = w; }
    }
};
struct EpiDown {
    static constexpr bool PERM = true, MID = false;
    bf16_t* CON; const PG8_LAS int* tokt; const PG8_LAS float* rowt;
    __device__ __forceinline__ void operator()(const f32x4 (&acc)[2][2][4][2], const Unit& u, int wr, int wc, int fr, int fq, int par) const {
        const int pl = u.pn & 3;
#pragma unroll
        for (int ai = 0; ai < 2; ++ai)
#pragma unroll
            for (int m = 0; m < 4; ++m) { const int r = ai * HALF + wr * 64 + m * 16 + fr; const bool ok = r < u.nv;
                const int slot = ok ? tokt[par * 256 + r] : 0; const float gt = rowt[par * 256 + r];
                bf16_t* rowp = CON + (size_t)slot * DM + pl * BM + wc * 32 + 8 * fq;
#pragma unroll
                for (int bj = 0; bj < 2; ++bj) { const f32x4 v0 = acc[ai][bj][m][0] * gt, v1 = acc[ai][bj][m][1] * gt;
                    u32x4 w; w.x = cvt_pk_bf16(v0[0], v0[1]); w.y = cvt_pk_bf16(v0[2], v0[3]); w.z = cvt_pk_bf16(v1[0], v1[1]); w.w = cvt_pk_bf16(v1[2], v1[3]);
                    if (ok) *(u32x4*)(rowp + bj * HALF) = w; } }
    }
};

template <class Epi, class Sched, bool ALIGN_EPI = false>
__device__ __forceinline__ void gemm_phase(PG8_LAS unsigned char* lds, const Gemm g, const Sched& S, const Epi& E) {
    const int tid = threadIdx.x, wid = __builtin_amdgcn_readfirstlane(tid >> 6), lane = tid & 63, wr = wid >> 2, wc = wid & 3, fr = lane & 15, fq = lane >> 4;
    const int K = g.K, nt = K / BK;
    int Rr[2], Cc[2]; unsigned voffB[2];
#pragma unroll
    for (int i = 0; i < 2; ++i) { int R, C; stage_rc(tid * 16 + i * 8192, R, C); const int Rb = Epi::PERM ? ((R & ~31) + perm32(R & 31)) : R;
        Rr[i] = R; Cc[i] = C; voffB[i] = (unsigned)(Rb * K + C) * 2u; }
    const size_t kstep = (size_t)(BK * 2);
    const size_t hstep = (size_t)HALF * K * 2;
    const size_t tstep = 2 * hstep;
    const unsigned ldsw = (unsigned)wid * 1024u;
    const int aoff = lds_byte(wr * 64 + fr, fq * 8), boff = lds_byte(wc * 32 + fr, fq * 8);
#define PG8_SA(b, h) (((b) * 2 + (h)) * HTB)
#define PG8_SB(b, h) ((4 + (b) * 2 + (h)) * HTB)
#define PG8_STAGE(bufoff, gbase, voff) do { _Pragma("unroll") for (int _i = 0; _i < 2; ++_i) \
        __builtin_amdgcn_global_load_lds((const unsigned*)((const char*)(gbase) + (voff)[_i]), (PG8_LAS unsigned*)(lds + (bufoff) + ldsw + _i * 8192), 16, 0, 0); } while (0)
#define PG8_LDA(dst, b, h) do { _Pragma("unroll") for (int m = 0; m < 4; ++m) _Pragma("unroll") for (int k = 0; k < 2; ++k) dst[m][k] = *(const PG8_LAS bf16x8*)(lds + PG8_SA(b, h) + aoff + m * 2048 + k * 1024); } while (0)
#define PG8_LDB(dst, b, h) do { _Pragma("unroll") for (int n = 0; n < 2; ++n) _Pragma("unroll") for (int k = 0; k < 2; ++k) dst[n][k] = *(const PG8_LAS bf16x8*)(lds + PG8_SB(b, h) + boff + n * 2048 + k * 1024); } while (0)
#define PG8_MMA(ai, bj, At, Bt) do { __builtin_amdgcn_s_setprio(1); _Pragma("unroll") for (int m = 0; m < 4; ++m) _Pragma("unroll") for (int n = 0; n < 2; ++n) _Pragma("unroll") for (int k = 0; k < 2; ++k) \
        acc[ai][bj][m][n] = __builtin_amdgcn_mfma_f32_16x16x32_bf16(Bt[n][k], At[m][k], acc[ai][bj][m][n], 0, 0, 0); __builtin_amdgcn_s_setprio(0); } while (0)
#define PG8_WAIT_V(n) asm volatile("s_waitcnt vmcnt(" #n ")" ::: "memory")
#define PG8_WAIT_L(n) asm volatile("s_waitcnt lgkmcnt(" #n ")" ::: "memory")
#define PG8_BAR __builtin_amdgcn_s_barrier()
#define PG8_SCHED __builtin_amdgcn_sched_barrier(0)
    Unit cur, nxt; int ui = 0;
    if (!S.next(0, cur)) return;
    f32x4 acc[2][2][4][2];
#pragma unroll
    for (int a = 0; a < 2; ++a)
#pragma unroll
        for (int b = 0; b < 2; ++b)
#pragma unroll
            for (int m = 0; m < 4; ++m)
#pragma unroll
                for (int n = 0; n < 2; ++n) acc[a][b][m][n] = (f32x4){0.f, 0.f, 0.f, 0.f};
    bf16x8 At[4][2], B0[2][2], B1[2][2];
    unsigned vA[2][2], nvA[2][2];
    if constexpr (Sched::FETCH) { S.fetch(cur, 0); PG8_WAIT_V(0); PG8_BAR; }
#pragma unroll
    for (int h = 0; h < 2; ++h)
#pragma unroll
        for (int i = 0; i < 2; ++i) vA[h][i] = Sched::GATHER ? S.row_off(cur, h * HALF + Rr[i], 0) + (unsigned)Cc[i] * 2u : (unsigned)((h * HALF + Rr[i]) * K + Cc[i]) * 2u;
    const char* cA = Sched::GATHER ? (const char*)g.A : (const char*)g.A + (size_t)cur.pm * tstep; const char* cB = (const char*)g.Bt + (size_t)cur.pn * tstep;
    if constexpr (Epi::MID) E.prep(cur, 0);
    PG8_STAGE(PG8_SB(0, 0), cB, voffB); PG8_STAGE(PG8_SB(0, 1), cB + hstep, voffB); PG8_STAGE(PG8_SA(0, 0), cA, vA[0]); PG8_STAGE(PG8_SA(0, 1), cA, vA[1]);
    if (wr == 1) PG8_BAR;
    PG8_WAIT_V(2); PG8_BAR;
    PG8_STAGE(PG8_SB(1, 0), cB + kstep, voffB); PG8_STAGE(PG8_SA(1, 0), cA + kstep, vA[0]); PG8_STAGE(PG8_SB(1, 1), cB + hstep + kstep, voffB);
    PG8_WAIT_V(6); PG8_BAR;
    for (;;) {
        const bool has_next = S.next(ui + 1, nxt);
        const char* nA = has_next ? (Sched::GATHER ? (const char*)g.A : (const char*)g.A + (size_t)nxt.pm * tstep) : cA; const char* nB = has_next ? (const char*)g.Bt + (size_t)nxt.pn * tstep : cB;
        if constexpr (Sched::FETCH) { if (has_next) S.fetch(nxt, (ui + 1) % 3); }
#pragma unroll
        for (int h = 0; h < 2; ++h)
#pragma unroll
            for (int i = 0; i < 2; ++i) nvA[h][i] = vA[h][i];
        for (int t = 0; t < nt; t += 2) {
            const bool last = (t == nt - 2);
            if constexpr (Sched::GATHER) { if (last && has_next) {
#pragma unroll
                for (int h = 0; h < 2; ++h)
#pragma unroll
                    for (int i = 0; i < 2; ++i) nvA[h][i] = S.row_off(nxt, h * HALF + Rr[i], (ui + 1) % 3) + (unsigned)Cc[i] * 2u; } }
            if constexpr (Epi::MID) { if (t == nt / 2) E.mid(acc, ui & 1, wr, fr); }
            const char* a1 = cA + (size_t)(t + 1) * kstep;
            const char* a2 = last ? nA : cA + (size_t)(t + 2) * kstep; const char* b2 = last ? nB : cB + (size_t)(t + 2) * kstep;
            const char* a3 = a2 + kstep; const char* b3 = b2 + kstep;
            unsigned o2[2][2];
#pragma unroll
            for (int h = 0; h < 2; ++h)
#pragma unroll
                for (int i = 0; i < 2; ++i) o2[h][i] = last ? nvA[h][i] : vA[h][i];
            PG8_LDB(B0, 0, 0); PG8_LDB(B1, 0, 1); PG8_SCHED; PG8_LDA(At, 0, 0); PG8_STAGE(PG8_SA(1, 1), a1, vA[1]);
            PG8_WAIT_V(8); PG8_WAIT_L(0); PG8_BAR; PG8_MMA(0, 0, At, B0); PG8_MMA(0, 1, At, B1); PG8_BAR; PG8_SCHED;
            PG8_LDA(At, 0, 1); PG8_STAGE(PG8_SB(0, 0), b2, voffB); PG8_STAGE(PG8_SB(0, 1), b2 + hstep, voffB); PG8_STAGE(PG8_SA(0, 0), a2, o2[0]);
            PG8_WAIT_V(8); PG8_WAIT_L(0); PG8_BAR; PG8_MMA(1, 0, At, B0); PG8_MMA(1, 1, At, B1); PG8_BAR; PG8_SCHED;
            PG8_LDB(B0, 1, 0); PG8_LDB(B1, 1, 1); PG8_SCHED; PG8_LDA(At, 1, 0); PG8_STAGE(PG8_SA(0, 1), a2, o2[1]);
            PG8_WAIT_V(8); PG8_WAIT_L(0); PG8_BAR; PG8_MMA(0, 0, At, B0); PG8_MMA(0, 1, At, B1); PG8_BAR; PG8_SCHED;
            PG8_LDA(At, 1, 1); PG8_STAGE(PG8_SB(1, 0), b3, voffB); PG8_STAGE(PG8_SB(1, 1), b3 + hstep, voffB); PG8_STAGE(PG8_SA(1, 0), a3, o2[0]);
            PG8_WAIT_V(8); PG8_WAIT_L(0); PG8_BAR; PG8_MMA(1, 0, At, B0); PG8_MMA(1, 1, At, B1); PG8_BAR; PG8_SCHED;
        }
        if constexpr (ALIGN_EPI) { if (wr == 0) PG8_BAR; }
        if constexpr (Epi::MID) { E(acc, cur, wr, wc, fr, fq, ui & 1); if (has_next) E.prep(nxt, (ui + 1) & 1); }
        else if constexpr (Sched::FETCH) E(acc, cur, wr, wc, fr, fq, ui % 3);
        else E(acc, cur, wr, wc, fr, fq);
        if (!has_next) break;
#pragma unroll
        for (int a = 0; a < 2; ++a)
#pragma unroll
            for (int b = 0; b < 2; ++b)
#pragma unroll
                for (int m = 0; m < 4; ++m)
#pragma unroll
                    for (int n = 0; n < 2; ++n) acc[a][b][m][n] = (f32x4){0.f, 0.f, 0.f, 0.f};
        cur = nxt; cA = nA; cB = nB; ++ui;
#pragma unroll
        for (int h = 0; h < 2; ++h)
#pragma unroll
            for (int i = 0; i < 2; ++i) vA[h][i] = nvA[h][i];
        if constexpr (ALIGN_EPI) { if (wr == 1) PG8_BAR; }
    }
    PG8_WAIT_V(0);
    if constexpr (!ALIGN_EPI) { if (wr == 0) PG8_BAR; }
    PG8_BAR;
#undef PG8_SA
#undef PG8_SB
#undef PG8_STAGE
#undef PG8_LDA
#undef PG8_LDB
#undef PG8_MMA
#undef PG8_WAIT_V
#undef PG8_WAIT_L
#undef PG8_BAR
#undef PG8_SCHED
}
}

namespace attn_body {
using bf16 = __hip_bfloat16;
using bf16x8 = __attribute__((ext_vector_type(8))) short;
using s16x4 = __attribute__((ext_vector_type(4))) short;
using f32x16 = __attribute__((ext_vector_type(16))) float;
using u32x4 = __attribute__((ext_vector_type(4))) unsigned;
constexpr int D = 64;
constexpr int NW = 8, QBLK = 32, QB = QBLK * NW, KVBLK = 64;
__device__ __forceinline__ int crow(int r, int hi) { return (r & 3) + 8 * (r >> 2) + 4 * hi; }
#define SBAR() __builtin_amdgcn_sched_barrier(0)
constexpr int NSLOT = 3, SLOTB = 8192;
constexpr int LDS_K = 0, LDS_V = NSLOT * SLOTB, LDS_WS = 2 * NSLOT * SLOTB, LDS_OST = LDS_WS + NW * 64 * 4, LDS_BYTES = LDS_OST + NW * 4096;
__device__ __forceinline__ void glds16(const void* gsrc, unsigned lds_dst) { unsigned keep;
  asm volatile("s_mov_b32 %0, m0\n\ts_mov_b32 m0, %2\n\ts_nop 0\n\tglobal_load_lds_dwordx4 %1, off\n\ts_mov_b32 m0, %0" : "=&s"(keep) : "v"(gsrc), "s"(lds_dst) : "memory"); }
__device__ __forceinline__ float max3f(float a, float b, float c) { float r; asm("v_max3_f32 %0, %1, %2, %3" : "=v"(r) : "v"(a), "v"(b), "v"(c)); return r; }
__device__ __forceinline__ float max2f(float a, float b) { float r; asm("v_max_f32_e32 %0, %1, %2" : "=v"(r) : "v"(a), "v"(b)); return r; }
__device__ __forceinline__ float fadd_s(float a, float b) { float r; asm("v_add_f32_e32 %0, %1, %2" : "=v"(r) : "v"(a), "v"(b)); return r; }
__device__ __forceinline__ float fsub_s(float a, float b) { float r; asm("v_sub_f32_e32 %0, %1, %2" : "=v"(r) : "v"(a), "v"(b)); return r; }
typedef float f32x2_t __attribute__((ext_vector_type(2))); typedef __bf16 bf16x2_t __attribute__((ext_vector_type(2)));
__device__ __forceinline__ unsigned cvtpk_s(float lo, float hi) { f32x2_t v = {lo, hi}; bf16x2_t b = __builtin_convertvector(v, bf16x2_t); return __builtin_bit_cast(unsigned, b); }
#define WAIT_BAR(N) asm volatile("s_waitcnt vmcnt(" #N ") lgkmcnt(0)\n\ts_barrier" ::: "memory")

__device__ __forceinline__ void qkt(f32x16& p0, f32x16& p1, const char* Kslot, const bf16x8* qr, const f32x16& negm, int r32, int hi) {
  const char* kb = Kslot + hi * 1024 + r32 * 16;
  #pragma unroll
  for (int d0 = 0; d0 < 4; ++d0) {
    const bf16x8 b0 = *reinterpret_cast<const bf16x8*>(kb + d0 * 2048);
    const bf16x8 b1 = *reinterpret_cast<const bf16x8*>(kb + d0 * 2048 + 512);
    if (d0 == 0) { p0 = __builtin_amdgcn_mfma_f32_32x32x16_bf16(b0, qr[0], negm, 0, 0, 0); p1 = __builtin_amdgcn_mfma_f32_32x32x16_bf16(b1, qr[0], negm, 0, 0, 0); }
    else { p0 = __builtin_amdgcn_mfma_f32_32x32x16_bf16(b0, qr[d0], p0, 0, 0, 0); p1 = __builtin_amdgcn_mfma_f32_32x32x16_bf16(b1, qr[d0], p1, 0, 0, 0); } }
}
typedef __attribute__((address_space(3))) const char* lds_cptr;
typedef short v4i16_t __attribute__((ext_vector_type(4)));
__device__ __forceinline__ void kload8(bf16x8* kf, lds_cptr kp) {
  kf[0] = *(const __attribute__((address_space(3))) bf16x8*)(kp);        kf[1] = *(const __attribute__((address_space(3))) bf16x8*)(kp + 512);
  kf[2] = *(const __attribute__((address_space(3))) bf16x8*)(kp + 2048); kf[3] = *(const __attribute__((address_space(3))) bf16x8*)(kp + 2560);
  kf[4] = *(const __attribute__((address_space(3))) bf16x8*)(kp + 4096); kf[5] = *(const __attribute__((address_space(3))) bf16x8*)(kp + 4608);
  kf[6] = *(const __attribute__((address_space(3))) bf16x8*)(kp + 6144); kf[7] = *(const __attribute__((address_space(3))) bf16x8*)(kp + 6656);
}
__device__ __forceinline__ void kload2(bf16x8* kf, lds_cptr kp, int j) { kf[2 * j] = *(const __attribute__((address_space(3))) bf16x8*)(kp + j * 2048); kf[2 * j + 1] = *(const __attribute__((address_space(3))) bf16x8*)(kp + j * 2048 + 512); }
__device__ __forceinline__ s16x4 vtr(lds_cptr p) { return __builtin_bit_cast(s16x4, __builtin_amdgcn_ds_read_tr16_b64_v4i16((__attribute__((address_space(3))) v4i16_t*)p)); }
__device__ __forceinline__ float rowmax(const f32x16& p0, const f32x16& p1) {
  float a = max3f(p0[0], p0[1], p1[0]), b = max3f(p0[2], p0[3], p1[1]); a = max3f(a, p1[2], p1[3]);
  #pragma unroll
  for (int r = 4; r < 16; r += 4) { a = max3f(a, p0[r], p0[r + 1]); b = max3f(b, p0[r + 2], p0[r + 3]); a = max3f(a, p1[r], p1[r + 1]); b = max3f(b, p1[r + 2], p1[r + 3]); }
  const float m = max2f(a, b);
  auto rr = __builtin_amdgcn_permlane32_swap(__float_as_uint(m), __float_as_uint(m), false, false);
  return max2f(__uint_as_float(rr[0]), __uint_as_float(rr[1]));
}
__device__ __forceinline__ void pv(f32x16* o, int vb, bf16x8 pa0, bf16x8 pa1, bf16x8 pa2, bf16x8 pa3) {
  #pragma unroll
  for (int d0 = 0; d0 < 2; ++d0) { s16x4 lo[4], hi[4];
    #pragma unroll
    for (int ks = 0; ks < 4; ++ks) {
      asm volatile("ds_read_b64_tr_b16 %0,%1 offset:%c2" : "=&v"(lo[ks]) : "v"(vb), "i"(d0 * 4096 + ks * 1024) : "memory");
      asm volatile("ds_read_b64_tr_b16 %0,%1 offset:%c2" : "=&v"(hi[ks]) : "v"(vb), "i"(d0 * 4096 + ks * 1024 + 512) : "memory"); }
    asm volatile("s_waitcnt lgkmcnt(0)" ::: "memory"); SBAR();
    #define PK(k) (bf16x8){lo[k][0], lo[k][1], lo[k][2], lo[k][3], hi[k][0], hi[k][1], hi[k][2], hi[k][3]}
    o[d0] = __builtin_amdgcn_mfma_f32_32x32x16_bf16(pa0, PK(0), o[d0], 0, 0, 0);
    o[d0] = __builtin_amdgcn_mfma_f32_32x32x16_bf16(pa1, PK(1), o[d0], 0, 0, 0);
    o[d0] = __builtin_amdgcn_mfma_f32_32x32x16_bf16(pa2, PK(2), o[d0], 0, 0, 0);
    o[d0] = __builtin_amdgcn_mfma_f32_32x32x16_bf16(pa3, PK(3), o[d0], 0, 0, 0);
    #undef PK
  }
}

#define ATTN_STORE16(p, v) (*(u32x4*)(p) = (v))
template <int THRL, int QP, int KP, int VP, int OP> __device__ __forceinline__ void attn_unit(const bf16* Qw0, const bf16* __restrict__ Kh, const bf16* __restrict__ Vh, bf16* Ow0, float* ssq0, const bool FIXREF  , float sref, int NT, char* shm) {
  const int tid = threadIdx.x, lane = tid & 63, r32 = lane & 31, hi = lane >> 5; const int wid = __builtin_amdgcn_readfirstlane(tid >> 6);
  const bf16* Qw = Qw0 + (long)(wid * QBLK) * QP;
  const unsigned lds0 = (unsigned)(uintptr_t)shm;
  float* wsf = (float*)(shm + LDS_WS) + wid * 64;
  const bf16* ksrc = (KP == 0) ? Kh + wid * 512 + lane * 8 : Kh + (long)lane * KP + wid * 8;
  const bf16* vsrc = (KP == 0) ? Vh + wid * 512 + lane * 8 : Vh + (long)(16 * (wid & 3) + (lane >> 2)) * VP + (wid >> 2) * 32 + (lane & 3) * 8;
  const unsigned kdst = lds0 + LDS_K + wid * 1024, vdst = lds0 + LDS_V + wid * 1024;
  #define DMA_K(t, slot) glds16(ksrc + (long)(t) * ((KP == 0) ? 4096 : KVBLK * KP), (unsigned)__builtin_amdgcn_readfirstlane(kdst + (slot)))
  #define DMA_V(t, slot) glds16(vsrc + (long)(t) * ((VP == 0) ? 4096 : KVBLK * VP), (unsigned)__builtin_amdgcn_readfirstlane(vdst + (slot)))
  const int vb0 = (int)(lds0 + LDS_V) + ((lane >> 4) & 1) * 32 + (lane & 3) * 8 + (4 * hi + ((lane & 15) >> 2)) * 64;
  const char* Kbase = shm + LDS_K; bf16x8 kf[8];
  const lds_cptr shm3 = (lds_cptr)shm; const lds_cptr kp0 = shm3 + LDS_K + hi * 1024 + r32 * 16; const lds_cptr vp0 = shm3 + LDS_V + ((lane >> 4) & 1) * 32 + (lane & 3) * 8 + (4 * hi + ((lane & 15) >> 2)) * 64;
  DMA_K(0, 0); DMA_V(0, 0); DMA_K(1, SLOTB);
  bf16x8 qr[4];
  #pragma unroll
  for (int d0 = 0; d0 < 4; ++d0) qr[d0] = *reinterpret_cast<const bf16x8*>(&Qw[(long)r32 * QP + d0 * 16 + hi * 8]);
  float mhat = 0.f, l_reg = 0.f; f32x16 o[2]; o[0] = f32x16{}; o[1] = f32x16{}; f32x16 negm = f32x16{};
  if (FIXREF) { _Pragma("unroll") for (int r = 0; r < 16; ++r) negm[r] = -sref; }
  asm volatile("" : "+v"(negm));
  bool resc = false;
  #define START(P0, P1) do { resc = false; \
    if (!FIXREF) { const float rm = rowmax(P0, P1); const float dl = rm; mhat = fadd_s(mhat, dl); \
      _Pragma("unroll") for (int r = 0; r < 16; ++r) { P0[r] = fsub_s(P0[r], dl); P1[r] = fsub_s(P1[r], dl); } \
      _Pragma("unroll") for (int r = 0; r < 16; ++r) negm[r] = -mhat; asm volatile("" : "+v"(negm)); } \
    _Pragma("unroll") for (int r = 0; r < 16; ++r) P0[r] = __builtin_amdgcn_exp2f(P0[r]); } while (0)
  #define RESC() do { if (!FIXREF && resc) { asm volatile("s_waitcnt lgkmcnt(0)" ::: "memory"); \
      _Pragma("unroll") for (int d_ = 0; d_ < 2; ++d_) _Pragma("unroll") for (int r = 0; r < 16; ++r) o[d_][r] *= wsf[crow(r, hi)]; } } while (0)
  f32x16 pA0, pA1, pB0, pB1;
  int sl_prev = 0, sl_cur = 0, sl_next = SLOTB;
  #define ROT() do { sl_prev = sl_cur; sl_cur = sl_next; sl_next = (sl_next == (NSLOT - 1) * SLOTB) ? 0 : sl_next + SLOTB; } while (0)
  DMA_K(2, 2 * SLOTB);
  WAIT_BAR(3);
  qkt(pA0, pA1, Kbase, qr, negm, r32, hi); asm volatile("s_nop 15\n\ts_nop 7" : "+v"(pA0), "+v"(pA1));
  START(pA0, pA1);
  _Pragma("unroll") for (int r = 0; r < 16; ++r) pA1[r] = __builtin_amdgcn_exp2f(pA1[r]);
  WAIT_BAR(0);
  DMA_K(3, 0); DMA_V(1, SLOTB);
  ROT();
  kload8(kf, kp0 + sl_cur);
  WAIT_BAR(2);
  s16x4 vlo[8], vhi[8]; u32x4 pw0, pw1, pw2, pw3;
  #define PKW(P, B) cvtpk_s(P[B], P[B + 1])
  #define PAF(k) __builtin_bit_cast(bf16x8, pw##k)
  #define VFR(i) (bf16x8){vlo[i][0], vlo[i][1], vlo[i][2], vlo[i][3], vhi[i][0], vhi[i][1], vhi[i][2], vhi[i][3]}
  #define PIN(x) asm volatile("" : "+v"(x))
  #define MX3(a, b, c) __builtin_fmaxf(__builtin_fmaxf((a), (b)), (c))
  #define GAPA(MF, A0, A1, A2, A3, W0, W1, PW) do { MF; sacc += A0; sacc += A1; sacc += A2; sacc += A3; PIN(sacc); W0; W1; PIN(PW); SBAR(); } while (0)
  #define EX(v) __builtin_amdgcn_exp2f(v)
  #define GAPB(MF, X, B) do { MF; X[B] = EX(X[B]); X[B + 1] = EX(X[B + 1]); X[B + 2] = EX(X[B + 2]); X[B + 3] = EX(X[B + 3]); PIN(X); SBAR(); } while (0)
  #define VRD(i) do { vlo[i] = vtr(vp_ + (((i) >> 2) * 4096 + ((i) & 3) * 1024)); vhi[i] = vtr(vp_ + (((i) >> 2) * 4096 + ((i) & 3) * 1024 + 512)); } while (0)
  #define KRD(G, j) do { if (G) { kload2(kf, kp0 + sl_next, j); SBAR(); } } while (0)
  #define STEP(C0, C1, P0, P1, t, GK, GV, GL) do { SBAR(); \
    const lds_cptr vp_ = vp0 + sl_prev; \
    VRD(0); SBAR(); float sacc = (P0[0] + P0[1]); \
    GAPA(C0 = __builtin_amdgcn_mfma_f32_32x32x16_bf16(kf[0], qr[0], negm, 0, 0, 0), P0[2], P0[3], P0[4], P0[5],     pw0[0] = PKW(P0, 0), pw0[1] = PKW(P0, 2), pw0); \
    VRD(4); SBAR(); GAPA(C1 = __builtin_amdgcn_mfma_f32_32x32x16_bf16(kf[1], qr[0], negm, 0, 0, 0), P0[6], P0[7], P0[8], P0[9],     pw0[2] = PKW(P0, 4), pw0[3] = PKW(P0, 6), pw0); \
    VRD(1); SBAR(); GAPA(C0 = __builtin_amdgcn_mfma_f32_32x32x16_bf16(kf[2], qr[1], C0, 0, 0, 0),   P0[10], P0[11], P0[12], P0[13], pw1[0] = PKW(P0, 8), pw1[1] = PKW(P0, 10), pw1); \
    VRD(5); SBAR(); GAPA(C1 = __builtin_amdgcn_mfma_f32_32x32x16_bf16(kf[3], qr[1], C1, 0, 0, 0),   P0[14], P0[15], P1[0], P1[1],   pw1[2] = PKW(P0, 12), pw1[3] = PKW(P0, 14), pw1); \
    VRD(2); SBAR(); GAPA(C0 = __builtin_amdgcn_mfma_f32_32x32x16_bf16(kf[4], qr[2], C0, 0, 0, 0),   P1[2], P1[3], P1[4], P1[5],     pw2[0] = PKW(P1, 0), pw2[1] = PKW(P1, 2), pw2); \
    VRD(6); SBAR(); GAPA(C1 = __builtin_amdgcn_mfma_f32_32x32x16_bf16(kf[5], qr[2], C1, 0, 0, 0),   P1[6], P1[7], P1[8], P1[9],     pw2[2] = PKW(P1, 4), pw2[3] = PKW(P1, 6), pw2); \
    VRD(3); SBAR(); GAPA(C0 = __builtin_amdgcn_mfma_f32_32x32x16_bf16(kf[6], qr[3], C0, 0, 0, 0),   P1[10], P1[11], P1[12], P1[13], pw3[0] = PKW(P1, 8), pw3[1] = PKW(P1, 10), pw3); \
    VRD(7); SBAR(); GAPA(C1 = __builtin_amdgcn_mfma_f32_32x32x16_bf16(kf[7], qr[3], C1, 0, 0, 0),   P1[14], P1[15], 0.f, 0.f,       pw3[2] = PKW(P1, 12), pw3[3] = PKW(P1, 14), pw3); \
    l_reg += sacc; \
    if (GK) { DMA_K((t) + 3, sl_cur); } if (GV) { DMA_V((t) + 1, sl_next); } \
    if (!FIXREF) { float a = MX3(C0[0], C0[1], C1[0]), b = MX3(C0[2], C0[3], C1[1]); a = MX3(a, C1[2], C1[3]); \
      _Pragma("unroll") for (int r = 4; r < 16; r += 4) { a = MX3(a, C0[r], C0[r + 1]); b = MX3(b, C0[r + 2], C0[r + 3]); a = MX3(a, C1[r], C1[r + 1]); b = MX3(b, C1[r + 2], C1[r + 3]); } \
      float rm = __builtin_fmaxf(a, b); { auto rr = __builtin_amdgcn_permlane32_swap(__float_as_uint(rm), __float_as_uint(rm), false, false); rm = __builtin_fmaxf(__uint_as_float(rr[0]), __uint_as_float(rr[1])); } \
      resc = false; \
      if (__builtin_expect(__any(rm > (float)THRL), 0)) { const float dl = __builtin_fmaxf(rm, 0.f); mhat += dl; \
        _Pragma("unroll") for (int r = 0; r < 16; ++r) { C0[r] -= dl; C1[r] -= dl; } \
        _Pragma("unroll") for (int r = 0; r < 16; ++r) negm[r] = -mhat; asm volatile("" : "+v"(negm)); \
        const float f = __builtin_amdgcn_exp2f(-dl); l_reg *= f; if (hi == 0) wsf[r32] = f; resc = true; } } \
    SBAR(); \
    GAPB(o[0] = __builtin_amdgcn_mfma_f32_32x32x16_bf16(PAF(0), VFR(0), o[0], 0, 0, 0), C0, 0); \
    GAPB(o[1] = __builtin_amdgcn_mfma_f32_32x32x16_bf16(PAF(0), VFR(4), o[1], 0, 0, 0), C0, 4); \
    KRD(GL, 0); GAPB(o[0] = __builtin_amdgcn_mfma_f32_32x32x16_bf16(PAF(1), VFR(1), o[0], 0, 0, 0), C0, 8); \
    KRD(GL, 1); GAPB(o[1] = __builtin_amdgcn_mfma_f32_32x32x16_bf16(PAF(1), VFR(5), o[1], 0, 0, 0), C0, 12); \
    KRD(GL, 2); GAPB(o[0] = __builtin_amdgcn_mfma_f32_32x32x16_bf16(PAF(2), VFR(2), o[0], 0, 0, 0), C1, 0); \
    KRD(GL, 3); GAPB(o[1] = __builtin_amdgcn_mfma_f32_32x32x16_bf16(PAF(2), VFR(6), o[1], 0, 0, 0), C1, 4); \
    GAPB(o[0] = __builtin_amdgcn_mfma_f32_32x32x16_bf16(PAF(3), VFR(3), o[0], 0, 0, 0), C1, 8); \
    GAPB(o[1] = __builtin_amdgcn_mfma_f32_32x32x16_bf16(PAF(3), VFR(7), o[1], 0, 0, 0), C1, 12); \
    } while (0)
  int t = 1;
  for (; t + 5 < NT; t += 2) {
    STEP(pB0, pB1, pA0, pA1, t, true, true, true);     WAIT_BAR(2); RESC(); ROT();
    STEP(pA0, pA1, pB0, pB1, t + 1, true, true, true); WAIT_BAR(2); RESC(); ROT();
  }
  #define ENDW(tt) do { if ((tt) + 3 < NT) { WAIT_BAR(2); } else if ((tt) + 2 < NT) { WAIT_BAR(1); } else { WAIT_BAR(0); } } while (0)
  for (; t + 1 < NT; t += 2) {
    STEP(pB0, pB1, pA0, pA1, t, (t + 3 < NT), (t + 1 < NT), (t + 1 < NT));         ENDW(t);     RESC(); ROT();
    STEP(pA0, pA1, pB0, pB1, t + 1, (t + 4 < NT), (t + 2 < NT), (t + 2 < NT));     ENDW(t + 1); RESC(); ROT();
  }
  STEP(pB0, pB1, pA0, pA1, NT - 1, false, false, false); RESC();
  { float sacc = pB0[0] + pB0[1]; _Pragma("unroll") for (int r = 2; r < 16; ++r) sacc += pB0[r]; _Pragma("unroll") for (int r = 0; r < 16; ++r) sacc += pB1[r]; l_reg += sacc;
    pw0 = (u32x4){PKW(pB0, 0), PKW(pB0, 2), PKW(pB0, 4), PKW(pB0, 6)}; pw1 = (u32x4){PKW(pB0, 8), PKW(pB0, 10), PKW(pB0, 12), PKW(pB0, 14)}; pw2 = (u32x4){PKW(pB1, 0), PKW(pB1, 2), PKW(pB1, 4), PKW(pB1, 6)}; pw3 = (u32x4){PKW(pB1, 8), PKW(pB1, 10), PKW(pB1, 12), PKW(pB1, 14)};
    SBAR(); pv(o, vb0 + sl_cur, PAF(0), PAF(1), PAF(2), PAF(3)); }
  #undef PKW
  #undef PAF
  #undef VFR
  #undef PIN
  #undef MX3
  #undef GAPA
  #undef GAPB
  #undef EX
  #undef VRD
  #undef KRD
  #undef STEP
  #undef ENDW
  { auto rr = __builtin_amdgcn_permlane32_swap(__float_as_uint(l_reg), __float_as_uint(l_reg), false, false); l_reg = __uint_as_float(rr[0]) + __uint_as_float(rr[1]); }
  if (hi == 0) wsf[32 + r32] = l_reg; asm volatile("s_waitcnt lgkmcnt(0)" ::: "memory");
  float rli[16];
  #pragma unroll
  for (int r = 0; r < 16; ++r) rli[r] = __builtin_amdgcn_rcpf(wsf[32 + crow(r, hi)]);
  bf16* Ow = Ow0 + (long)(wid * QBLK) * OP;
  { bf16* stg = (bf16*)(shm + LDS_OST) + wid * 2048;
    #pragma unroll
    for (int r = 0; r < 16; ++r) { const int orow = crow(r, hi);
      #pragma unroll
      for (int d0 = 0; d0 < 2; ++d0) stg[orow * 64 + d0 * 32 + r32] = __float2bfloat16(o[d0][r] * rli[r]); }
    asm volatile("s_waitcnt lgkmcnt(0)" ::: "memory");
    #pragma unroll
    for (int i = 0; i < 4; ++i) { const int row = i * 8 + (lane >> 3), ch = lane & 7; const u32x4 v = *(const u32x4*)(stg + row * 64 + ch * 8); ATTN_STORE16(Ow + (long)row * OP + ch * 8, v);
      float sq = 0.f;
      #pragma unroll
      for (int j = 0; j < 4; ++j) { const float a = __uint_as_float(v[j] << 16), b = __uint_as_float(v[j] & 0xffff0000u); sq += a * a + b * b; }
      sq += __shfl_xor(sq, 1); sq += __shfl_xor(sq, 2); sq += __shfl_xor(sq, 4);
      if (ch == 0) atomicAdd(ssq0 + (wid * QBLK + row) * 2, sq); } }
  asm volatile("s_waitcnt lgkmcnt(0)\n\ts_barrier" ::: "memory");
  #undef DMA_K
  #undef DMA_V
  #undef START
  #undef RESC
  #undef ROT
}

#define MB_THR 8.0f
#define MB_NEG -1e30f
#define MB_ROWOFF(pos_) ((unsigned)((((pos_) < 0 ? 0 : ((pos_) >= Lsub ? Lsub - 1 : (pos_))) << dlsh) + res) * (unsigned)(P * 2))
#define MB_LOADK(KF, kt_) do { const unsigned ko_ = MB_ROWOFF(kstart + 32 * (kt_) + r32) + (unsigned)hi * 16u; \
    _Pragma("unroll") for (int d0 = 0; d0 < 4; ++d0) KF[d0] = *reinterpret_cast<const bf16x8*>((const char*)Kh + ko_ + d0 * 32); } while (0)
#define MB_LOADV(VV, kt_) do { const int kq0_ = kstart + 32 * (kt_); \
    _Pragma("unroll") for (int i = 0; i < 4; ++i) { const int c_ = i * 64 + lane, key_ = c_ >> 3, piece_ = c_ & 7; \
        VV[i] = *reinterpret_cast<const u32x4*>((const char*)Vh + MB_ROWOFF(kq0_ + key_) + (unsigned)piece_ * 16u); } } while (0)
#define MB_TILE(KF, KN, VF, VN, kt_) do { const int kp0_ = kstart + 32 * (kt_); \
    MB_LOADV(VN, (kt_) + 1); MB_LOADK(KN, (kt_) + 1); \
    f32x16 p = __builtin_amdgcn_mfma_f32_32x32x16_bf16(KF[0], qr[0], negm, 0, 0, 0); \
    p = __builtin_amdgcn_mfma_f32_32x32x16_bf16(KF[1], qr[1], p, 0, 0, 0); p = __builtin_amdgcn_mfma_f32_32x32x16_bf16(KF[2], qr[2], p, 0, 0, 0); p = __builtin_amdgcn_mfma_f32_32x32x16_bf16(KF[3], qr[3], p, 0, 0, 0); \
    const bool edge_ = (kp0_ < 0) || (kp0_ + 32 > Lsub); \
    if (edge_) { const int b0_ = kp0_ - qpos + 4 * hi + 64; \
        _Pragma("unroll") for (int r = 0; r < 16; ++r) { const int cr_ = (r & 3) + 8 * (r >> 2); \
            const bool ok_ = ((unsigned)(b0_ + cr_) <= 128u) && ((unsigned)(kp0_ + 4 * hi + cr_) < (unsigned)Lsub); p[r] = ok_ ? p[r] : MB_NEG; } } \
    else if (kp0_ - (qp0 + 31) < -64) { const int thr_ = qpos - 64 - kp0_ - 4 * hi;            \
        _Pragma("unroll") for (int r = 0; r < 16; ++r) { const int cr_ = (r & 3) + 8 * (r >> 2); p[r] = (cr_ >= thr_) ? p[r] : MB_NEG; } } \
    else if (kp0_ + 31 - qp0 > 64) { const int thr_ = qpos + 64 - kp0_ - 4 * hi;                 \
        _Pragma("unroll") for (int r = 0; r < 16; ++r) { const int cr_ = (r & 3) + 8 * (r >> 2); p[r] = (cr_ <= thr_) ? p[r] : MB_NEG; } } \
    if (!fixed) { \
        float mx_ = max3f(p[0], p[1], p[2]); \
        _Pragma("unroll") for (int r = 3; r < 15; r += 2) mx_ = max3f(mx_, p[r], p[r + 1]); \
        mx_ = fmaxf(mx_, p[15]); mx_ = fmaxf(mx_, __shfl_xor(mx_, 32)); \
        const bool need_ = (mx_ > -1e29f) && (setf == 0.f || mx_ > MB_THR); \
        if (__any(need_ ? 1 : 0)) { const float dlt_ = need_ ? mx_ : 0.f; const float alpha_ = (setf != 0.f) ? __builtin_amdgcn_exp2f(-dlt_) : 1.f; m_run += dlt_; setf = need_ ? 1.f : setf; \
            _Pragma("unroll") for (int r = 0; r < 16; ++r) { p[r] -= dlt_; negm[r] = -m_run; } \
            l_run *= alpha_; \
            _Pragma("unroll") for (int r = 0; r < 16; ++r) { const float a_ = __shfl(alpha_, crow(r, hi)); o[0][r] *= a_; o[1][r] *= a_; } } } \
    float s_ = 0.f; \
    _Pragma("unroll") for (int r = 0; r < 16; ++r) { p[r] = __builtin_amdgcn_exp2f(p[r]); s_ += p[r]; } \
    l_run += s_; \
    const u32x4 pw0_ = (u32x4){cvtpk_s(p[0], p[1]), cvtpk_s(p[2], p[3]), cvtpk_s(p[4], p[5]), cvtpk_s(p[6], p[7])}; \
    const u32x4 pw1_ = (u32x4){cvtpk_s(p[8], p[9]), cvtpk_s(p[10], p[11]), cvtpk_s(p[12], p[13]), cvtpk_s(p[14], p[15])}; \
    _Pragma("unroll") for (int i = 0; i < 4; ++i) { const int c_ = i * 64 + lane, key_ = c_ >> 3, piece_ = c_ & 7; \
        *(__attribute__((address_space(3))) u32x4*)((__attribute__((address_space(3))) char*)vt3 + (piece_ >> 2) * 2048 + key_ * 64 + (piece_ & 3) * 16) = VF[i]; } \
    asm volatile("s_waitcnt lgkmcnt(0)" ::: "memory"); \
    _Pragma("unroll") for (int dh = 0; dh < 2; ++dh) { \
        const s16x4 l0_ = vtr(vp0 + dh * 2048), h0_ = vtr(vp0 + dh * 2048 + 512), l1_ = vtr(vp0 + dh * 2048 + 1024), h1_ = vtr(vp0 + dh * 2048 + 1536); \
        const bf16x8 v0_ = (bf16x8){l0_[0], l0_[1], l0_[2], l0_[3], h0_[0], h0_[1], h0_[2], h0_[3]}, v1_ = (bf16x8){l1_[0], l1_[1], l1_[2], l1_[3], h1_[0], h1_[1], h1_[2], h1_[3]}; \
        o[dh] = __builtin_amdgcn_mfma_f32_32x32x16_bf16(__builtin_bit_cast(bf16x8, pw0_), v0_, o[dh], 0, 0, 0); \
        o[dh] = __builtin_amdgcn_mfma_f32_32x32x16_bf16(__builtin_bit_cast(bf16x8, pw1_), v1_, o[dh], 0, 0, 0); } \
    asm volatile("s_waitcnt lgkmcnt(0)" ::: "memory"); } while (0)

constexpr int MBL_ST = 32768, MBL_M = 512 * 64 * 2, MBL_L = MBL_M + 2048, MBL_BYTES = MBL_ST + MBL_L + 2048;
template <int P, int OP> __device__ __forceinline__ void mixb_item(const bf16* Qh, const bf16* Kh, const bf16* Vh, bf16* Oh, float* ssq0, char* blds, int tb, int lq0, int res, int dlsh, int mode, int nq, float kmax2, char* vt) {
    int lane_ = threadIdx.x & 63; asm volatile("" : "+v"(lane_));
    const int lane = lane_, r32 = lane & 31, hi = lane >> 5;
    const lds_cptr vt3 = (lds_cptr)vt; const lds_cptr vp0 = vt3 + ((lane >> 4) & 1) * 32 + (lane & 3) * 8 + (4 * hi + ((lane & 15) >> 2)) * 64;
    const int Lsub = SEQ >> dlsh;
    const int qp0 = (tb >> dlsh) + lq0, qpos = qp0 + (r32 & (nq - 1)), kstart = qp0 - 64;
    bf16x8 qr[4], kA[4], kB[4]; u32x4 vA[4], vB[4]; float qss = 0.f;
    #pragma unroll
    for (int d0 = 0; d0 < 4; ++d0) qr[d0] = *reinterpret_cast<const bf16x8*>(&Qh[(long)((qpos << dlsh) + res) * P + d0 * 16 + hi * 8]);
    MB_LOADK(kA, 0); MB_LOADV(vA, 0);
    #pragma unroll
    for (int d0 = 0; d0 < 4; ++d0) {
        #pragma unroll
        for (int j = 0; j < 8; ++j) { const float f = __uint_as_float((unsigned)(unsigned short)qr[d0][j] << 16); qss += f * f; } }
    qss += __shfl_xor(qss, 32);
    const float ref = sqrtf(qss * kmax2) * 1.03f + 0.25f;
    const bool fixed = !__any(ref > 40.0f ? 1 : 0);
    float m_run = fixed ? ref : 0.f, setf = fixed ? 1.f : 0.f, l_run = 0.f; f32x16 o[2]; o[0] = f32x16{}; o[1] = f32x16{}; f32x16 negm;
    #pragma unroll
    for (int r = 0; r < 16; ++r) negm[r] = -m_run;
    #pragma unroll 1
    for (int kt = 0; kt < 4; kt += 2) { MB_TILE(kA, kB, vA, vB, kt); MB_TILE(kB, kA, vB, vA, kt + 1); }
    MB_TILE(kA, kB, vA, vB, 4);
    l_run += __shfl_xor(l_run, 32);
    typedef __attribute__((address_space(3))) char* lds_ptr;
    const lds_ptr st = (lds_ptr)blds + MBL_ST;
    #define MB_LDSU16(p_) (*(__attribute__((address_space(3))) unsigned short*)(p_))
    #define MB_LDSF32(p_) (*(__attribute__((address_space(3))) float*)(p_))
    if (mode == 0) {
        #pragma unroll
        for (int r = 0; r < 16; ++r) { const int row = ((lq0 + crow(r, hi)) << dlsh) + res;
            MB_LDSU16(st + row * 128 + r32 * 2) = (unsigned short)cvtpk_s(o[0][r], 0.f); MB_LDSU16(st + row * 128 + 64 + r32 * 2) = (unsigned short)cvtpk_s(o[1][r], 0.f); }
        if (hi == 0) { const int row = ((lq0 + r32) << dlsh) + res; MB_LDSF32(st + MBL_M + row * 4) = m_run; MB_LDSF32(st + MBL_L + row * 4) = l_run; }
    } else {
        const int ri = ((lq0 + r32) << dlsh) + res;
        const float mP = MB_LDSF32(st + MBL_M + ri * 4), lP = MB_LDSF32(st + MBL_L + ri * 4);
        const float Mx = fmaxf(mP, m_run); float a = __builtin_amdgcn_exp2f(mP - Mx), b = __builtin_amdgcn_exp2f(m_run - Mx);
        const float lsum = a * lP + b * l_run;
        if (mode == 2) { const float inv = __builtin_amdgcn_rcpf(lsum); a *= inv; b *= inv; }
        const lds_ptr stg = (lds_ptr)vt;
        #pragma unroll
        for (int r = 0; r < 16; ++r) { const int q = crow(r, hi); const float aq = __shfl(a, q), bq = __shfl(b, q); const int row = ((lq0 + q) << dlsh) + res;
            const float op0 = __uint_as_float((unsigned)MB_LDSU16(st + row * 128 + r32 * 2) << 16), op1 = __uint_as_float((unsigned)MB_LDSU16(st + row * 128 + 64 + r32 * 2) << 16);
            const unsigned short w0 = (unsigned short)cvtpk_s(aq * op0 + bq * o[0][r], 0.f), w1 = (unsigned short)cvtpk_s(aq * op1 + bq * o[1][r], 0.f);
            if (mode == 2) { MB_LDSU16(stg + q * 128 + r32 * 2) = w0; MB_LDSU16(stg + q * 128 + 64 + r32 * 2) = w1; }
            else           { MB_LDSU16(st + row * 128 + r32 * 2) = w0; MB_LDSU16(st + row * 128 + 64 + r32 * 2) = w1; } }
        if (mode == 1) { if (hi == 0) { MB_LDSF32(st + MBL_M + ri * 4) = Mx; MB_LDSF32(st + MBL_L + ri * 4) = lsum; } }
        else {
            asm volatile("s_waitcnt lgkmcnt(0)" ::: "memory");
            #pragma unroll
            for (int i = 0; i < 4; ++i) { const int row = i * 8 + (lane >> 3), ch = lane & 7; const u32x4 v = *(const __attribute__((address_space(3))) u32x4*)(stg + row * 128 + ch * 16);
                const long tok = tb + ((lq0 + row) << dlsh) + res;
                *(u32x4*)(Oh + tok * OP + ch * 8) = v;
                float sq = 0.f;
                #pragma unroll
                for (int j = 0; j < 4; ++j) { const float a_ = __uint_as_float(v[j] << 16), b_ = __uint_as_float(v[j] & 0xffff0000u); sq += a_ * a_ + b_ * b_; }
                sq += __shfl_xor(sq, 1); sq += __shfl_xor(sq, 2); sq += __shfl_xor(sq, 4);
                if (ch == 0) atomicAdd(ssq0 + tok * 2, sq); }
            asm volatile("s_waitcnt lgkmcnt(0)" ::: "memory");
        }
    }
    #undef MB_LDSU16
    #undef MB_LDSF32
}
#undef SBAR
#undef WAIT_BAR
}

constexpr int NWAVES = 8;
constexpr int N_PHASES = 10;
constexpr int N_LAUNCHES = MK_N_LAUNCHES;
static_assert(N_LAUNCHES == 1 || N_LAUNCHES == N_PHASES, "MK_N_LAUNCHES is 1 or 10");

constexpr size_t MiB = 1u << 20;
constexpr size_t WS_CTL = 0, CTL_ZERO_BYTES = 1 * MiB;
constexpr size_t WS_ROPE = 1 * MiB;
constexpr size_t WS_WR = 5 * MiB;
constexpr size_t WS_WIN = 6 * MiB;
constexpr size_t WS_WOUT = 11 * MiB;
constexpr size_t WS_WGU = 13 * MiB;
constexpr size_t WS_WD = 77 * MiB;
constexpr size_t WS_LIST = 109 * MiB;
constexpr size_t WS_GATEV = 117 * MiB;
constexpr size_t WS_RSTD2 = 118 * MiB;
constexpr size_t WS_XN = 120 * MiB;
constexpr size_t WS_CAT = 248 * MiB;
constexpr size_t WS_PROJ = 376 * MiB;
constexpr size_t WS_KIMG = 664 * MiB;
constexpr size_t WS_VIMG = 680 * MiB;
constexpr size_t WS_MBQKV = 696 * MiB;
constexpr size_t WS_H = 888 * MiB;
constexpr size_t WS_HDN = 248 * MiB;
constexpr size_t WS_CON = 384 * MiB;
constexpr size_t WS_MIXS = 920 * MiB;
constexpr size_t WS_SRS = 990 * MiB;
constexpr size_t WS_SGATE = 998 * MiB;
constexpr size_t WS_END = 1006 * MiB;
static_assert(WS_HDN + (size_t)(2 * M + NEXP * 256) * DEXP * 2 <= WS_CON && WS_CON + (size_t)2 * M * DM * 2 <= WS_KIMG && WS_MBQKV + (size_t)3 * M * 512 * 2 <= WS_H && WS_H <= WS_MIXS, "d_ws map");
constexpr int CW_TMO = 0, CW_CODE = 1;
constexpr int CW_BAR = 4096;
constexpr int CW_CNT = 16384;
constexpr int CW_KMAX = 16448;
constexpr int CW_SSQ = 65536;

constexpr int RING_OFF = 0, RING_BYTES = 131072;
constexpr int LDSCTL_OFF = RING_BYTES, MISC_OFF = LDSCTL_OFF + 320;
constexpr int LDS_BYTES = 147456;
static_assert(MISC_OFF + 128 <= LDS_BYTES, "LDS map");

#define GAS __attribute__((address_space(1)))
#define LAS __attribute__((address_space(3)))
typedef unsigned short bf16;
typedef unsigned v4u __attribute__((ext_vector_type(4)));
typedef unsigned v2u __attribute__((ext_vector_type(2)));
typedef float f32x4 __attribute__((ext_vector_type(4)));
typedef short bf16x8 __attribute__((ext_vector_type(8)));
typedef GAS unsigned gu32;
#define RLX_AGENT __ATOMIC_RELAXED, __HIP_MEMORY_SCOPE_AGENT
#define LDS_WAIT() asm volatile("s_waitcnt lgkmcnt(0)" ::: "memory")
#define VM_WAIT() asm volatile("s_waitcnt vmcnt(0)" ::: "memory")
__device__ __forceinline__ unsigned f2bf(float f) { unsigned u = __builtin_bit_cast(unsigned, f); return (u + 0x7fffu + ((u >> 16) & 1u)) >> 16; }
__device__ __forceinline__ unsigned pk2(float lo, float hi) { return f2bf(lo) | (f2bf(hi) << 16); }
__device__ __forceinline__ float bflo(unsigned w) { return __builtin_bit_cast(float, w << 16); }
__device__ __forceinline__ float bfhi(unsigned w) { return __builtin_bit_cast(float, w & 0xffff0000u); }

#define XB_TMO      128
#define XB_XCNT(j)  (256  + 64 * (j))
#define XB_XSUB(j)  (1280 + 64 * (j))
#define XB_XGEN(j)  (2304 + 64 * (j))
#define XB_TOP      3328
#define XB_TOPGEN   3392
#define XCD_BAR_WORDS 3456
#define XB_SPIN_CAP (1u << 18)
__device__ __forceinline__ unsigned xb_ld(unsigned* p)              { return __hip_atomic_load(p, __ATOMIC_RELAXED, __HIP_MEMORY_SCOPE_AGENT); }
__device__ __forceinline__ unsigned xb_add(unsigned* p, unsigned v) { return __hip_atomic_fetch_add(p, v, __ATOMIC_RELAXED, __HIP_MEMORY_SCOPE_AGENT); }
__device__ __forceinline__ unsigned xb_xcc_id() { return (unsigned)__builtin_amdgcn_s_getreg((3 << 11) | 20) & 0xFu; }
#define XB_SPIN(cond, bar) do { unsigned _sp = 0; while (cond) { __builtin_amdgcn_s_sleep(1); \
    if ((++_sp & 255u) == 0u) { if (xb_ld(&(bar)[XB_TMO])) break; if (_sp > XB_SPIN_CAP) { atomicAdd(&(bar)[XB_TMO], 1u); break; } } } } while (0)
struct XcdBarrier { unsigned* bar; unsigned x; volatile LAS unsigned* st; };
__device__ __forceinline__ XcdBarrier xcd_barrier_post(unsigned* bar, volatile LAS unsigned* st) {
    XcdBarrier b; b.bar = bar; b.x = xb_xcc_id(); b.st = st;
    if (threadIdx.x == 0) (void)xb_add(&bar[XB_XCNT(b.x)], 1u);
    return b;
}
__device__ __forceinline__ void xcd_barrier_complete(unsigned* bar, unsigned x, unsigned& nloc, unsigned& nx) {
    const unsigned G = gridDim.x * gridDim.y * gridDim.z;
    unsigned sum, cnt, mine, sp = 0u;
    for (;;) {
        sum = 0u; cnt = 0u; mine = 0u;
#pragma unroll
        for (unsigned j = 0; j < 16; ++j) { const unsigned c = xb_ld(&bar[XB_XCNT(j)]); sum += c; cnt += (c > 0u) ? 1u : 0u; mine = (j == x) ? c : mine; }
        if (sum == G) break;
        __builtin_amdgcn_s_sleep(1);
        if ((++sp & 255u) == 0u) { if (xb_ld(&bar[XB_TMO])) break; if (sp > XB_SPIN_CAP) { atomicAdd(&bar[XB_TMO], 1u); break; } }
    }
    nloc = mine > 0u ? mine : 1u; nx = cnt > 0u ? cnt : 1u;
}
__device__ __forceinline__ void xcd_barrier(const XcdBarrier& b) {
    asm volatile("s_waitcnt vmcnt(0)" ::: "memory");
    __syncthreads();
    if (threadIdx.x == 0) {
        unsigned* bar = b.bar;
        __builtin_amdgcn_s_waitcnt(0);
        unsigned nloc = b.st[0], nx = b.st[1];
        if (nloc == 0u) { xcd_barrier_complete(bar, b.x, nloc, nx); b.st[0] = nloc; b.st[1] = nx; }
        const unsigned old = xb_add(&bar[XB_XSUB(b.x)], 1u);
        const unsigned gen = old / nloc;
        if (old + 1u == (gen + 1u) * nloc) {
            __builtin_amdgcn_fence(__ATOMIC_RELEASE, "agent");
            asm volatile("s_waitcnt vmcnt(0)" ::: "memory");
            const unsigned og = xb_add(&bar[XB_TOP], 1u);
            const unsigned tg = og / nx;
            if (og + 1u == (tg + 1u) * nx) xb_add(&bar[XB_TOPGEN], 1u);
            else XB_SPIN(xb_ld(&bar[XB_TOPGEN]) == tg, bar);
            __builtin_amdgcn_fence(__ATOMIC_ACQUIRE, "agent");
            xb_add(&bar[XB_XGEN(b.x)], 1u);
            asm volatile("s_waitcnt vmcnt(0)" ::: "memory");
        } else {
            XB_SPIN(xb_ld(&bar[XB_XGEN(b.x)]) == gen, bar);
            __builtin_amdgcn_fence(__ATOMIC_ACQUIRE, "agent");
            asm volatile("s_waitcnt vmcnt(0)" ::: "memory");
        }
    }
    __syncthreads();
}

struct Frame {
    LAS unsigned char* lds;
    volatile LAS unsigned* MISC;
    gu32* ctl;
    int tid, lane, wave;
    int vcu, G;
    const float *x, *n1g, *w_in, *qng, *kng, *onga, *ongb, *w_out, *n2g, *rgw, *rgb, *rew, *reb, *wg, *wu, *wd, *fng; float* out;
    unsigned char* ws;
};
__device__ __forceinline__ float wave_sum(float v) {
#pragma unroll
    for (int o = 1; o < 64; o <<= 1) v += __shfl_xor(v, o);
    return v;
}
template <class F> __device__ __forceinline__ void tr_item(const F& f, int K, bf16* WT0  , int k0, LAS float* scr, int lane) {
#pragma unroll 8
    for (int i = 0; i < 32; ++i) { const int kk = 2 * i + (lane >> 5); scr[kk * 33 + (lane & 31)] = f.load(k0 + kk, lane & 31); }
    LDS_WAIT(); asm volatile("" ::: "memory");
    const int c = lane & 7;
#pragma unroll
    for (int j = 0; j < 4; ++j) { const int n = (lane >> 3) + 8 * j; const LAS float* s = scr + (8 * c) * 33 + n;
        v4u o; o.x = pk2(s[0 * 33], s[1 * 33]); o.y = pk2(s[2 * 33], s[3 * 33]); o.z = pk2(s[4 * 33], s[5 * 33]); o.w = pk2(s[6 * 33], s[7 * 33]);
        *(GAS v4u*)(WT0 + (size_t)n * K + k0 + 8 * c) = o; }
    LDS_WAIT(); asm volatile("" ::: "memory");
}
struct LdPlain { const float* W; int N, n0; __device__ __forceinline__ float load(int k, int n) const { return W[(size_t)k * N + n0 + n]; } };
struct LdPlainG2 { const float* W; int N, n0; const float* ga; const float* gb;
    __device__ __forceinline__ float load(int k, int n) const { return W[(size_t)k * N + n0 + n] * (k < 512 ? ga[k] : gb[k - 512]); } };
struct LdRope256 { const float* W; int N, n0;
    __device__ __forceinline__ float load(int k, int n) const { const int nd = n0 + n; return W[(size_t)k * N + (nd & ~255) + pg8::ropemap256(nd & 255)]; } };
struct LdGateUp { const float* Wg; const float* Wu; const float* g2; int j0;
    __device__ __forceinline__ float load(int k, int n) const { const unsigned long long pa = (unsigned long long)Wg, pb = (unsigned long long)Wu; const bool isg = ((n >> 2) & 1) == 0;
        const unsigned lo = isg ? (unsigned)pa : (unsigned)pb, hi = isg ? (unsigned)(pa >> 32) : (unsigned)(pb >> 32);
        const float* Wm = (const float*)(((unsigned long long)hi << 32) | lo); return Wm[(size_t)k * DEXP + j0 + (n >> 3) * 8 + (n & 3)] * g2[k]; } };

__device__ __forceinline__ void p0_prologue(Frame& F) {
    LAS float* scr = (LAS float*)(F.lds + RING_OFF + F.wave * 16384);
    const int gw = F.vcu * NWAVES + F.wave, NGW = F.G * NWAVES;
    bf16* Win_t = (bf16*)(F.ws + WS_WIN); bf16* Wout_t = (bf16*)(F.ws + WS_WOUT); bf16* Wgu_t = (bf16*)(F.ws + WS_WGU); bf16* Wd_t = (bf16*)(F.ws + WS_WD); bf16* Wr_t = (bf16*)(F.ws + WS_WR);
    constexpr int I_IN = (DM / 64) * (NPROJ / 32), I_OUT = (DM / 64) * (DM / 32), I_GU1 = (DM / 64) * (1024 / 32), I_D1 = (DEXP / 64) * (DM / 32);
    constexpr int NITEMS = I_IN + I_OUT + NEXP * I_GU1 + NEXP * I_D1;
    for (int it = gw; it < NITEMS; it += NGW) {
        int r = it;
        if (r < I_IN) { const int nblk = NPROJ / 32, kb = r / nblk, nb = r % nblk; LdRope256 f{F.w_in, NPROJ, 32 * nb}; tr_item(f, DM, Win_t + (size_t)(32 * nb) * DM, 64 * kb, scr, F.lane); continue; } r -= I_IN;
        if (r < I_OUT) { const int nblk = DM / 32, kb = r / nblk, nb = r % nblk; LdPlainG2 f{F.w_out, DM, 32 * nb, F.onga, F.ongb}; tr_item(f, DM, Wout_t + (size_t)(32 * nb) * DM, 64 * kb, scr, F.lane); continue; } r -= I_OUT;
        if (r < NEXP * I_GU1) { const int e = r / I_GU1, q = r % I_GU1, kb = q / 32, nb = q % 32;
            LdGateUp f{F.wg + (size_t)e * DM * DEXP, F.wu + (size_t)e * DM * DEXP, F.n2g, 128 * (nb >> 3) + 32 * (nb & 3) + 4 * ((nb >> 2) & 1)}; tr_item(f, DM, Wgu_t + ((size_t)e * 1024 + 32 * nb) * DM, 64 * kb, scr, F.lane); continue; } r -= NEXP * I_GU1;
        { const int e = r / I_D1, q = r % I_D1, nblk = DM / 32, kb = q / nblk, nb = q % nblk; LdPlain f{F.wd + (size_t)e * DEXP * DM, DM, 32 * nb}; tr_item(f, DEXP, Wd_t + ((size_t)e * DM + 32 * nb) * DEXP, 64 * kb, scr, F.lane); }
    }
    for (int idx = gw * 64 + F.lane; idx < 48 * DM; idx += NGW * 64) { const int c = idx >> 10, k = idx & 1023;
        float v = 0.f; if (c < 4) v = F.rgw[k * 4 + c]; else if (c < 36) v = F.rew[k * 32 + (c - 4)];
        Wr_t[idx] = (bf16)f2bf(v * F.n2g[k]); }
    { float* cosA = (float*)(F.ws + WS_ROPE); float* sinA = cosA + SEQ * 32; float* cosB = sinA + SEQ * 32; float* sinB = cosB + SEQ * 32;
      const int j = F.lane & 31, ja = j & 15;
      const double l2b = 13.287712379549449, i2pi = 0.15915494309189535;
      const double cB = exp2(-(double)(2 * j) * (1.0 / 64.0) * l2b) * i2pi, cA = exp2(-(double)(2 * ja) * (1.0 / 32.0) * l2b) * i2pi;
      for (int idx = gw * 64 + F.lane; idx < SEQ * 32; idx += NGW * 64) { const int t = idx >> 5;
          double pB = (double)t * cB; pB -= floor(pB); const float rB = (float)pB;
          cosB[idx] = __builtin_amdgcn_cosf(rB); sinB[idx] = __builtin_amdgcn_sinf(rB);
          const int pos = (j < 16) ? (t >> 6) : (t & 63);
          double pA = (double)pos * cA; pA -= floor(pA); const float rA = (float)pA;
          cosA[idx] = __builtin_amdgcn_cosf(rA); sinA[idx] = __builtin_amdgcn_sinf(rA); } }
    { bf16* XN = (bf16*)(F.ws + WS_XN);
      f32x4 gv[4];
#pragma unroll
      for (int j = 0; j < 4; ++j) gv[j] = *((const GAS f32x4*)F.n1g + F.lane + 64 * j);
      for (int m = gw; m < M; m += NGW) { const GAS f32x4* xr = (const GAS f32x4*)(F.x + (size_t)m * DM) + F.lane;
          f32x4 v[4]; float s = 0.f;
#pragma unroll
          for (int j = 0; j < 4; ++j) { v[j] = xr[64 * j]; s += (v[j].x * v[j].x + v[j].y * v[j].y) + (v[j].z * v[j].z + v[j].w * v[j].w); }
          const float rstd = 1.f / sqrtf(wave_sum(s) * (1.f / DM) + EPS);
          GAS unsigned long long* o8 = (GAS unsigned long long*)(XN + (size_t)m * DM) + F.lane;
#pragma unroll
          for (int j = 0; j < 4; ++j) o8[64 * j] = (unsigned long long)pk2(v[j].x * rstd * gv[j].x, v[j].y * rstd * gv[j].y) | ((unsigned long long)pk2(v[j].z * rstd * gv[j].z, v[j].w * rstd * gv[j].w) << 32); } }
}

__device__ __forceinline__ void p6_router(Frame& F) {
    const bf16* HB = (const bf16*)(F.ws + WS_XN); const bf16* Wr_t = (const bf16*)(F.ws + WS_WR);
    int* list = (int*)(F.ws + WS_LIST); float* srs = (float*)(F.ws + WS_SRS); float* sgate = (float*)(F.ws + WS_SGATE);
    LAS float* lg = (LAS float*)(F.lds + RING_OFF) + F.wave * (32 * 48);
    LAS int* lcnt = (LAS int*)(F.lds + RING_OFF + 65536);
    const int lane = F.lane, fr = lane & 15, fq = lane >> 4;
    for (int ch = F.vcu; ch < M / 256; ch += F.G) {
        if (F.tid < 64) lcnt[F.tid] = 0;
        __syncthreads();
        const int tok0 = ch * 256 + F.wave * 32;
        f32x4 acc[2][3];
#pragma unroll
        for (int a = 0; a < 2; ++a)
#pragma unroll
            for (int b = 0; b < 3; ++b) acc[a][b] = (f32x4){0.f, 0.f, 0.f, 0.f};
        float ss0 = 0.f, ss1 = 0.f;
        const bf16* a0p = HB + (size_t)(tok0 + fr) * DM + 8 * fq; const bf16* a1p = a0p + (size_t)16 * DM;
        const bf16* bp = Wr_t + (size_t)fr * DM + 8 * fq;
#pragma unroll 8
        for (int ks = 0; ks < DM / 32; ++ks) {
            const bf16x8 a0 = *(const bf16x8*)(a0p + ks * 32), a1 = *(const bf16x8*)(a1p + ks * 32);
            const bf16x8 b0 = *(const bf16x8*)(bp + ks * 32), b1 = *(const bf16x8*)(bp + (size_t)16 * DM + ks * 32), b2 = *(const bf16x8*)(bp + (size_t)32 * DM + ks * 32);
#pragma unroll
            for (int j = 0; j < 8; ++j) { const float f0 = __builtin_bit_cast(float, (unsigned)(unsigned short)a0[j] << 16), f1 = __builtin_bit_cast(float, (unsigned)(unsigned short)a1[j] << 16); ss0 += f0 * f0; ss1 += f1 * f1; }
            acc[0][0] = __builtin_amdgcn_mfma_f32_16x16x32_bf16(a0, b0, acc[0][0], 0, 0, 0); acc[0][1] = __builtin_amdgcn_mfma_f32_16x16x32_bf16(a0, b1, acc[0][1], 0, 0, 0); acc[0][2] = __builtin_amdgcn_mfma_f32_16x16x32_bf16(a0, b2, acc[0][2], 0, 0, 0);
            acc[1][0] = __builtin_amdgcn_mfma_f32_16x16x32_bf16(a1, b0, acc[1][0], 0, 0, 0); acc[1][1] = __builtin_amdgcn_mfma_f32_16x16x32_bf16(a1, b1, acc[1][1], 0, 0, 0); acc[1][2] = __builtin_amdgcn_mfma_f32_16x16x32_bf16(a1, b2, acc[1][2], 0, 0, 0);
        }
        ss0 += __shfl_xor(ss0, 16); ss0 += __shfl_xor(ss0, 32); ss1 += __shfl_xor(ss1, 16); ss1 += __shfl_xor(ss1, 32);
#pragma unroll
        for (int a = 0; a < 2; ++a)
#pragma unroll
            for (int b = 0; b < 3; ++b)
#pragma unroll
                for (int j = 0; j < 4; ++j) lg[(a * 16 + 4 * fq + j) * 48 + b * 16 + fr] = acc[a][b][j];
        LDS_WAIT(); asm volatile("" ::: "memory");
        int e1 = 0, e2 = 0, pos1 = 0, pos2 = 0; float gt1 = 0.f, gt2 = 0.f, rs = 0.f;
        if (lane < 32) {
            rs = 1.f / sqrtf(((lane < 16) ? ss0 : ss1) * (1.f / DM) + EPS);
            const LAS float* L = lg + lane * 48;
            float g[4]; float gmax = -INFINITY; int gi = 0;
#pragma unroll
            for (int c = 0; c < 4; ++c) { g[c] = L[c] * rs + F.rgb[c]; if (g[c] > gmax) { gmax = g[c]; gi = c; } }
            float gs = 0.f;
#pragma unroll
            for (int c = 0; c < 4; ++c) gs += __expf(g[c] - gmax);
            const float gp = 1.0f / gs;
            float l1 = -INFINITY, l2 = -INFINITY; int i1 = 0, i2 = 0;
#pragma unroll
            for (int j = 0; j < 8; ++j) { const float v = L[4 + gi * 8 + j] * rs + F.reb[gi * 8 + j];
                if (v > l1) { l2 = l1; i2 = i1; l1 = v; i1 = j; } else if (v > l2) { l2 = v; i2 = j; } }
            const float p1 = 1.0f / (1.0f + __expf(l2 - l1));
            e1 = gi * 8 + i1; e2 = gi * 8 + i2; gt1 = gp * p1; gt2 = gp * (1.0f - p1);
            pos1 = atomicAdd((int*)&lcnt[e1], 1); pos2 = atomicAdd((int*)&lcnt[e2], 1);
        }
        __syncthreads();
        if (F.tid < 32) lcnt[32 + F.tid] = (int)atomicAdd((unsigned*)(F.ctl + CW_CNT + F.tid), (unsigned)lcnt[F.tid]);
        __syncthreads();
        if (lane < 32) { const int tok = tok0 + lane;
            const int i1 = e1 * LISTCAP + lcnt[32 + e1] + pos1, i2 = e2 * LISTCAP + lcnt[32 + e2] + pos2;
            list[i1] = tok * 2; list[i2] = tok * 2 + 1; srs[i1] = rs; srs[i2] = rs; sgate[i1] = gt1; sgate[i2] = gt2; }
        __syncthreads();
    }
}
__device__ __forceinline__ void moe_table(Frame& F) {
    LAS int* tst = (LAS int*)(F.lds + LDSCTL_OFF);
    if (F.tid < 64) {
        const int c = (F.lane < 32) ? (int)__hip_atomic_load(F.ctl + CW_CNT + F.lane, RLX_AGENT) : 0;
        int nt = (c + 255) >> 8, inc = nt;
#pragma unroll
        for (int o = 1; o < 32; o <<= 1) { const int v = __shfl_up(inc, o); if (F.lane >= o) inc += v; }
        if (F.lane < 32) { tst[F.lane] = inc - nt; tst[33 + F.lane] = c; if (F.lane == 31) tst[32] = inc; }
    }
    __syncthreads();
}
__device__ __forceinline__ void p9_final(Frame& F) {
    const bf16* HB = (const bf16*)(F.ws + WS_XN); const bf16* CON = (const bf16*)(F.ws + WS_CON);
    const int gw = F.vcu * NWAVES + F.wave, NGW = F.G * NWAVES;
    f32x4 gv[4];
#pragma unroll
    for (int j = 0; j < 4; ++j) gv[j] = *((const GAS f32x4*)F.fng + F.lane + 64 * j);
    for (int m = gw; m < M; m += NGW) {
        const GAS v2u* hr = (const GAS v2u*)(HB + (size_t)m * DM) + F.lane;
        const GAS v2u* c0 = (const GAS v2u*)(CON + (size_t)(2 * m) * DM) + F.lane; const GAS v2u* c1 = (const GAS v2u*)(CON + (size_t)(2 * m + 1) * DM) + F.lane;
        f32x4 v[4]; float s = 0.f;
#pragma unroll
        for (int j = 0; j < 4; ++j) { const v2u h = hr[64 * j]; const v2u a = c0[64 * j], b = c1[64 * j];
            v[j].x = bflo(h.x) + (bflo(a.x) + bflo(b.x)); v[j].y = bfhi(h.x) + (bfhi(a.x) + bfhi(b.x)); v[j].z = bflo(h.y) + (bflo(a.y) + bflo(b.y)); v[j].w = bfhi(h.y) + (bfhi(a.y) + bfhi(b.y));
            s += (v[j].x * v[j].x + v[j].y * v[j].y) + (v[j].z * v[j].z + v[j].w * v[j].w); }
        const float rstd = 1.f / sqrtf(wave_sum(s) * (1.f / DM) + EPS);
        GAS f32x4* o = (GAS f32x4*)(F.out + (size_t)m * DM) + F.lane;
#pragma unroll
        for (int j = 0; j < 4; ++j) o[64 * j] = v[j] * rstd * gv[j];
    }
}

struct Args { const float* in[17]; float* out; unsigned char* ws; int ph_lo, ph_hi; };
__global__ void __launch_bounds__(NWAVES * 64, 2) skel_fwd(Args args) {
    extern __shared__ __attribute__((aligned(16))) unsigned char lds[];
    Frame F;
    F.lds = (LAS unsigned char*)lds;
    F.MISC = (volatile LAS unsigned*)(F.lds + MISC_OFF);
    F.tid = threadIdx.x; F.lane = F.tid & 63; F.wave = __builtin_amdgcn_readfirstlane(F.tid >> 6);
    F.G = gridDim.x; { const int bx = blockIdx.x; F.vcu = (F.G % 8 == 0) ? (bx % 8) * (F.G / 8) + bx / 8 : bx; }
    unsigned char* ws = args.ws; F.ws = ws;
    F.ctl = (gu32*)(ws + WS_CTL);
    F.x = args.in[0]; F.n1g = args.in[1]; F.w_in = args.in[2]; F.qng = args.in[3]; F.kng = args.in[4]; F.onga = args.in[5]; F.ongb = args.in[6]; F.w_out = args.in[7]; F.n2g = args.in[8];
    F.rgw = args.in[9]; F.rgb = args.in[10]; F.rew = args.in[11]; F.reb = args.in[12]; F.wg = args.in[13]; F.wu = args.in[14]; F.wd = args.in[15]; F.fng = args.in[16]; F.out = args.out;
    for (int u = F.tid; u < (LDS_BYTES - LDSCTL_OFF) / 4; u += NWAVES * 64) ((LAS unsigned*)(F.lds + LDSCTL_OFF))[u] = 0u;
    __syncthreads();
    XcdBarrier bar; bar.bar = (unsigned*)(F.ctl + CW_BAR); bar.x = 0; bar.st = nullptr;
    if (N_LAUNCHES == 1) bar = xcd_barrier_post((unsigned*)(F.ctl + CW_BAR), F.MISC + 8);
#define GRID_BAR() do { if (N_LAUNCHES == 1) xcd_barrier(bar); } while (0)
    const int lo = args.ph_lo, hi = args.ph_hi;
#define IN(k) (lo <= (k) && (k) < hi)
#define BOTH(k) (IN(k) && IN((k) + 1))
    bf16* XN = (bf16*)(ws + WS_XN); bf16* PROJ = (bf16*)(ws + WS_PROJ); bf16* CAT = (bf16*)(ws + WS_CAT);

    if (IN(0)) { p0_prologue(F); if (PROBE_DUP & 1) { GRID_BAR(); p0_prologue(F); } if (BOTH(0)) GRID_BAR(); }

    if (IN(1)) {
        pg8::Gemm g{XN, (const bf16*)(ws + WS_WIN), M, NPROJ, DM}; pg8::StaticOrder S; S.init(M, NPROJ, F.G, (int)blockIdx.x);
        const float* cosA = (const float*)(ws + WS_ROPE); const float* sinA = cosA + SEQ * 32; const float* cosB = sinA + SEQ * 32; const float* sinB = cosB + SEQ * 32;
        pg8::EpiProj E{PROJ, NPROJ, cosA, sinA, cosB, sinB, F.qng, F.kng, SEQ - 1, EPS, C2, (unsigned*)(F.ctl + CW_KMAX), 13, ws + WS_KIMG, ws + WS_VIMG, (bf16*)(ws + WS_MBQKV)};
        pg8::gemm_phase<pg8::EpiProj, pg8::StaticOrder, true>(F.lds + RING_OFF, g, S, E);
        if (PROBE_DUP & 2) { GRID_BAR(); pg8::gemm_phase<pg8::EpiProj, pg8::StaticOrder, true>(F.lds + RING_OFF, g, S, E); }
        if (IN(1) && IN(3)) GRID_BAR();
    }

    if (IN(3)) {
        using abf = attn_body::bf16;
        float* ssq = (float*)(F.ctl + CW_SSQ);
        float sref; { float gq = fabsf(F.qng[F.lane]), gk = fabsf(F.kng[F.lane]);
#pragma unroll
            for (int o_ = 1; o_ < 64; o_ <<= 1) { gq = fmaxf(gq, __shfl_xor(gq, o_)); gk = fmaxf(gk, __shfl_xor(gk, o_)); }
            sref = 64.0f * gq * gk * C2 * 1.03f + 0.25f; }
        const bool fixref = __builtin_amdgcn_readfirstlane(sref <= 40.0f ? 1 : 0) != 0;
        for (int rep = 0; rep < ((PROBE_DUP & 64) ? 2 : 1); ++rep)
        for (int i = 0;; ++i) {
            const int L = i * F.G + F.vcu; if (L >= BATCH * 8 * (SEQ / 256)) break;
            const int qb = L & 31, h = (L >> 5) & 7, b = L >> 8;
            const abf* Qw0 = (const abf*)PROJ + ((size_t)b * SEQ + (size_t)qb * 256) * NPROJ + h * 64;
            const abf* Kh = (const abf*)(ws + WS_KIMG) + (size_t)(b * 2 + (h >> 2)) * 128 * 4096;
            const abf* Vh = (const abf*)(ws + WS_VIMG) + (size_t)(b * 2 + (h >> 2)) * 128 * 4096;
            abf* Ow0 = (abf*)CAT + ((size_t)b * SEQ + (size_t)qb * 256) * DM + h * 64;
            attn_body::attn_unit<8, NPROJ, 0, 0, DM>(Qw0, Kh, Vh, Ow0, ssq + ((size_t)b * SEQ + (size_t)qb * 256) * 2, fixref, sref, SEQ / 64, (char*)lds + RING_OFF);
        }
        __syncthreads();
        { char* bl = (char*)lds + RING_OFF; char* vt = bl + F.wave * 4096;
          static_assert(attn_body::MBL_BYTES <= RING_BYTES, "mixer B LDS map");
          const unsigned* kmaxw = (const unsigned*)(F.ctl + CW_KMAX);
          for (int rep = 0; rep < ((PROBE_DUP & 4) ? 2 : 1); ++rep)
          for (int U = F.vcu; U < BATCH * 8 * 16; U += F.G) {
            const int blk = U & 15, h = (U >> 4) & 7, b = U >> 7, tb = blk * 512;
            const abf* base = (const abf*)(ws + WS_MBQKV) + (size_t)(b * 8 + h) * SEQ * 64;
            const abf* Qh = base; const abf* Kh = base + (size_t)64 * SEQ * 64; const abf* Vh = base + (size_t)128 * SEQ * 64;
            abf* Oh = (abf*)CAT + (size_t)b * SEQ * DM + 512 + h * 64; float* ssqb = (rep == 0) ? ssq + (size_t)b * SEQ * 2 + 1 : (float*)(ws + WS_GATEV);
            const float kmax2 = __uint_as_float(kmaxw[b * 8 + h]);
            #pragma unroll 1
            for (int it = 0; it < 6; ++it) {
                const int j = F.wave + 8 * (it & 1), mode = it >> 1, dlsh = 2 * mode;
                const int lq0 = (mode == 0) ? 32 * j : (mode == 1) ? 32 * (j >> 2) : 0, res = (mode == 0) ? 0 : (mode == 1) ? (j & 3) : j;
                attn_body::mixb_item<64, DM>(Qh, Kh, Vh, Oh, ssqb, bl, tb, lq0, res, dlsh, mode, 32, kmax2, vt);
                if (it & 1) __syncthreads();
            }
          } }
        if (IN(3) && IN(5)) GRID_BAR();
    }

    if (IN(5)) {
        pg8::Gemm g{CAT, (const bf16*)(ws + WS_WOUT), M, DM, DM}; pg8::StaticOrder S; S.init(M, DM, F.G, (int)blockIdx.x);
        pg8::EpiH E{F.x, XN, DM, (const float*)(F.ctl + CW_SSQ), (LAS float*)(F.lds + LDSCTL_OFF + 512), EPS};
        pg8::gemm_phase<pg8::EpiH, pg8::StaticOrder, true>(F.lds + RING_OFF, g, S, E);
        if (PROBE_DUP & 8) { GRID_BAR(); pg8::gemm_phase<pg8::EpiH, pg8::StaticOrder, true>(F.lds + RING_OFF, g, S, E); }
        if (BOTH(5)) GRID_BAR();
    }
    if (IN(6)) { p6_router(F); if (BOTH(6)) GRID_BAR(); }

    if (IN(7)) {
        moe_table(F);
        pg8::Gemm g{XN, (const bf16*)(ws + WS_WGU), 0, 1024, DM};
        pg8::MoeOrder<true> S{F.G, F.vcu, (const LAS int*)(F.lds + LDSCTL_OFF), (const int*)(ws + WS_LIST), (LAS int*)(F.lds + LDSCTL_OFF + 4608), (const float*)(ws + WS_SRS), (LAS float*)(F.lds + LDSCTL_OFF + 7680)};
        pg8::EpiGU E{(bf16*)(ws + WS_HDN), (const LAS float*)(F.lds + LDSCTL_OFF + 7680)};
        pg8::gemm_phase<pg8::EpiGU, pg8::MoeOrder<true>, true>(F.lds + RING_OFF, g, S, E);
        if (PROBE_DUP & 16) { GRID_BAR(); pg8::gemm_phase<pg8::EpiGU, pg8::MoeOrder<true>, true>(F.lds + RING_OFF, g, S, E); }
        if (BOTH(7)) GRID_BAR();
    }
    if (IN(8)) {
        moe_table(F);
        pg8::Gemm g{(const bf16*)(ws + WS_HDN), (const bf16*)(ws + WS_WD), 0, DM, DEXP};
        pg8::MoeOrder<false> S{F.G, F.vcu, (const LAS int*)(F.lds + LDSCTL_OFF), (const int*)(ws + WS_LIST), (LAS int*)(F.lds + LDSCTL_OFF + 4608), (const float*)(ws + WS_SGATE), (LAS float*)(F.lds + LDSCTL_OFF + 7680)};
        pg8::EpiDown E{(bf16*)(ws + WS_CON), (const LAS int*)(F.lds + LDSCTL_OFF + 4608), (const LAS float*)(F.lds + LDSCTL_OFF + 7680)};
        pg8::gemm_phase<pg8::EpiDown, pg8::MoeOrder<false>, true>(F.lds + RING_OFF, g, S, E);
        if (PROBE_DUP & 128) { GRID_BAR(); pg8::gemm_phase<pg8::EpiDown, pg8::MoeOrder<false>, true>(F.lds + RING_OFF, g, S, E); }
        if (BOTH(8)) GRID_BAR();
    }
    if (IN(9)) { p9_final(F); if (PROBE_DUP & 32) { GRID_BAR(); p9_final(F); } }
#undef IN
#undef BOTH
}

extern "C" void kernel_launch(void* const* d_in, const int* in_sizes, int n_in, void* d_out, int out_size, void* d_ws, size_t ws_size, hipStream_t stream) {
    static int grid = 0;
    if (grid == 0) {
        if (n_in != 17 || in_sizes[0] != M * DM || out_size != M * DM || ws_size < WS_END) { fprintf(stderr, "kernel_launch: unexpected shapes (n_in %d, in0 %d, out %d, ws %zu)\n", n_in, n_in > 0 ? in_sizes[0] : -1, out_size, ws_size); grid = -1; return; }
        int dev = 0, cus = 0, per_cu = 0;
        if (hipGetDevice(&dev) != hipSuccess || hipDeviceGetAttribute(&cus, hipDeviceAttributeMultiprocessorCount, dev) != hipSuccess) { grid = -1; return; }
        if (hipFuncSetAttribute((const void*)skel_fwd, hipFuncAttributeMaxDynamicSharedMemorySize, LDS_BYTES) != hipSuccess) { fprintf(stderr, "kernel_launch: hipFuncSetAttribute failed\n"); grid = -1; return; }
        if (hipOccupancyMaxActiveBlocksPerMultiprocessor(&per_cu, (const void*)skel_fwd, NWAVES * 64, LDS_BYTES) != hipSuccess || per_cu < 1)
            fprintf(stderr, "kernel_launch: note: occupancy query reports %d workgroups per CU\n", per_cu);
        (void)hipGetLastError();
        grid = cus;
    }
    if (grid < 0) return;
    if (hipMemsetAsync((char*)d_ws + WS_CTL, 0, CTL_ZERO_BYTES, stream) != hipSuccess) return;
    Args a{};
    for (int i = 0; i < 17; ++i) a.in[i] = (const float*)d_in[i];
    a.out = (float*)d_out; a.ws = (unsigned char*)d_ws;
    if (N_LAUNCHES == 1) { a.ph_lo = 0; a.ph_hi = N_PHASES; hipLaunchKernelGGL(skel_fwd, dim3(grid), dim3(NWAVES * 64), LDS_BYTES, stream, a); }
    else for (int li = 0; li < N_PHASES; ++li) { a.ph_lo = li; a.ph_hi = li + 1; hipLaunchKernelGGL(skel_fwd, dim3(grid), dim3(NWAVES * 64), LDS_BYTES, stream, a); }
}
```

```cpp
#include <hip/hip_runtime.h>
#include <hip/hip_bf16.h>
#include <cstdio>
#include <cstdint>
#include <cmath>

#ifndef PROBE_DUP
#define PROBE_DUP 0
#endif
#ifndef MK_N_LAUNCHES
#define MK_N_LAUNCHES 1
#endif

constexpr int BATCH = 8, SEQ = 8192, DM = 1024, M = BATCH * SEQ;
constexpr int NPROJ = 2304;
constexpr int NEXP = 32, DEXP = 512, LISTCAP = 65536;
constexpr float EPS = 1e-6f;
constexpr float C2 = 0.125f * 1.4426950408889634f;

namespace pg8 {
#define PG8_LAS __attribute__((address_space(3)))
typedef unsigned short bf16_t;
typedef short bf16x8 __attribute__((ext_vector_type(8)));
typedef float f32x4 __attribute__((ext_vector_type(4)));
typedef unsigned u32x4 __attribute__((ext_vector_type(4)));
typedef unsigned u32x2 __attribute__((ext_vector_type(2)));
typedef float f32x2v __attribute__((ext_vector_type(2)));
constexpr int BM = 256, BK = 64, HALF = 128, HTB = HALF * BK * 2, STAGE_BYTES = 8 * HTB, NXCD = 8, WGM = 4;

__host__ __device__ __forceinline__ int lds_byte(int r, int c) { const int st = (r >> 4) * 2 + (c >> 5), rr = r & 15, cc = c & 31, ob = rr * 64 + cc * 2; return st * 1024 + (ob ^ (((ob >> 9) & 1) << 5)); }
__host__ __device__ __forceinline__ void stage_rc(int b, int& R, int& C) { const int st = b / 1024, sb = b % 1024, swz = sb ^ (((sb >> 9) & 1) << 5); R = (st >> 1) * 16 + swz / 64; C = (st & 1) * 32 + (swz % 64) / 2; }
__host__ __device__ __forceinline__ int perm32(int rho) { const int n = rho >> 4, i = rho & 15; return 8 * (i >> 2) + 4 * n + (i & 3); }

struct Unit { int pm, pn, nv, lb; };
struct Gemm { const bf16_t* A; const bf16_t* Bt; int M, N, K; };

struct StaticOrder {
    static constexpr bool GATHER = false, FETCH = false;
    int nM, nN, nwg, G, c;
    __host__ __device__ void init(int M_, int N_, int G_, int c_) { nM = M_ / BM; nN = N_ / BM; nwg = nM * nN; G = G_; c = c_; }
    __host__ __device__ bool next(int i, Unit& u) const {
        const long L = (long)i * G + c; if (L >= nwg) return false;
        int wgid = (int)L; { const int q = nwg / NXCD, r = nwg % NXCD, xcd = wgid % NXCD, off = wgid / NXCD; wgid = (xcd < r ? xcd * (q + 1) : r * (q + 1) + (xcd - r) * q) + off; }
        const int nig = WGM * nN, gid = wgid / nig, fm = gid * WGM, gsz = (nM - fm) < WGM ? (nM - fm) : WGM;
        u.pm = fm + ((wgid % nig) % gsz); u.pn = (wgid % nig) / gsz; u.nv = 256; u.lb = 0; return true;
    }
    __device__ __forceinline__ void fetch(const Unit&, int) const {}
    __device__ __forceinline__ unsigned row_off(const Unit&, int, int) const { return 0u; }
};
template <bool GATHER_> struct MoeOrder {
    int G, c; const PG8_LAS int* tst; const int* list; PG8_LAS int* tokt; const float* rowf; PG8_LAS float* rowt;
    static constexpr bool GATHER = GATHER_, FETCH = true;
    __device__ __forceinline__ bool next(int i, Unit& u) const {
        const int L = i * G + c, T = L >> 2;
        if (T >= tst[32]) return false;
        int e = 0;
#pragma unroll
        for (int j = 0; j < 31; ++j) e += (tst[j + 1] <= T) ? 1 : 0;
        const int rel = T - tst[e], cnt = tst[33 + e];
        int nv = cnt - rel * 256; nv = nv > 256 ? 256 : nv;
        u.pm = __builtin_amdgcn_readfirstlane(T); u.pn = __builtin_amdgcn_readfirstlane(e * 4 + (L & 3)); u.nv = __builtin_amdgcn_readfirstlane(nv); u.lb = __builtin_amdgcn_readfirstlane(e * LISTCAP + rel * 256);
        return true;
    }
    __device__ __forceinline__ void fetch(const Unit& u, int par) const {
        const int tid = threadIdx.x;
        const int w = __builtin_amdgcn_readfirstlane(tid >> 6);
        if (tid < 256) __builtin_amdgcn_global_load_lds((const unsigned*)(list + u.lb + tid), (PG8_LAS unsigned*)(tokt + par * 256 + w * 64), 4, 0, 0);
        else           __builtin_amdgcn_global_load_lds((const unsigned*)(rowf + u.lb + (tid - 256)), (PG8_LAS unsigned*)(rowt + par * 256 + (w - 4) * 64), 4, 0, 0);
    }
    __device__ __forceinline__ unsigned row_off(const Unit& u, int r, int par) const { const int slot = tokt[par * 256 + r]; return (r < u.nv) ? (unsigned)(slot >> 1) * 2048u : 0u; }
};

__device__ __forceinline__ unsigned cvt_pk_bf16(float lo, float hi) { unsigned r; asm volatile("v_cvt_pk_bf16_f32 %0, %1, %2" : "=v"(r) : "v"(lo), "v"(hi)); return r; }

struct EpiBf16 {
    static constexpr bool PERM = true, MID = false;
    bf16_t* O; int ldc;
    __device__ __forceinline__ void operator()(const f32x4 (&acc)[2][2][4][2], const Unit& u, int wr, int wc, int fr, int fq) const {
        const int row0 = u.pm * BM + wr * 64 + fr, col0 = u.pn * BM + wc * 32 + 8 * fq;
#pragma unroll
        for (int ai = 0; ai < 2; ++ai)
#pragma unroll
            for (int m = 0; m < 4; ++m) { bf16_t* rowp = O + (size_t)(row0 + ai * HALF + m * 16) * ldc + col0;
#pragma unroll
                for (int bj = 0; bj < 2; ++bj) { const f32x4 v0 = acc[ai][bj][m][0], v1 = acc[ai][bj][m][1];
                    u32x4 w; w.x = cvt_pk_bf16(v0[0], v0[1]); w.y = cvt_pk_bf16(v0[2], v0[3]); w.z = cvt_pk_bf16(v1[0], v1[1]); w.w = cvt_pk_bf16(v1[2], v1[3]);
                    *(u32x4*)(rowp + bj * HALF) = w; } }
    }
};
__host__ __device__ __forceinline__ int ropemap256(int c) { return 64 * ((c >> 5) & 3) + 16 * (c >> 7) + 4 * ((c >> 3) & 3) + (c & 3) + 32 * ((c >> 2) & 1); }
struct EpiProj {
    static constexpr bool PERM = true, MID = false;
    bf16_t* O; int ldc; const float* cosA; const float* sinA; const float* cosB; const float* sinB; const float* qng; const float* kng; int seqmask; float eps, qscale; unsigned* kmax; int seqshift; unsigned char* kimg; unsigned char* vimg; bf16_t* mbq;
    __device__ __forceinline__ void operator()(const f32x4 (&acc)[2][2][4][2], const Unit& u, int wr, int wc, int fr, int fq) const {
        const int pn = u.pn;
        const bool isqa = pn < 2, iska = (pn == 2) && (wc < 2), isqb = (pn == 3 || pn == 4), iskb = (pn == 5 || pn == 6);
        const bool donorm = isqa || iska, dorope = donorm || isqb || iskb;
        const float sc = (isqa || isqb) ? qscale : 1.0f;
        const float* ct = donorm ? cosA : cosB; const float* st = donorm ? sinA : sinB;
        f32x4 g1[2], g2[2];
#pragma unroll
        for (int bj = 0; bj < 2; ++bj) { g1[bj] = (f32x4){1.f, 1.f, 1.f, 1.f}; g2[bj] = g1[bj]; }
        if (donorm) { const float* gp = isqa ? qng : kng;
#pragma unroll
            for (int bj = 0; bj < 2; ++bj) { g1[bj] = *(const f32x4*)(gp + 16 * bj + 4 * fq); g2[bj] = *(const f32x4*)(gp + 32 + 16 * bj + 4 * fq); } }
        const int row0 = u.pm * BM + wr * 64 + fr;
        const int col16 = (fq & 1) ? (4 * fq - 4) : (32 + 4 * fq);
        float kss_max = 0.f;
#pragma unroll
        for (int am = 0; am < 4; ++am) { const int ai = am >> 1;
            f32x4 tc[4][2], ts[4][2];
            if (dorope) {
#pragma unroll
                for (int m = 2 * (am & 1); m < 2 * (am & 1) + 2; ++m) { const int t = (row0 + ai * HALF + m * 16) & seqmask;
#pragma unroll
                    for (int bj = 0; bj < 2; ++bj) { tc[m][bj] = *(const f32x4*)(ct + t * 32 + 16 * bj + 4 * fq); ts[m][bj] = *(const f32x4*)(st + t * 32 + 16 * bj + 4 * fq); } } }
#pragma unroll
            for (int m = 2 * (am & 1); m < 2 * (am & 1) + 2; ++m) { const int row = row0 + ai * HALF + m * 16;
                f32x4 x1[2], x2[2];
#pragma unroll
                for (int bj = 0; bj < 2; ++bj) { x1[bj] = acc[ai][bj][m][0]; x2[bj] = acc[ai][bj][m][1]; }
                if (donorm) { float ss = 0.f;
#pragma unroll
                    for (int bj = 0; bj < 2; ++bj) ss += (x1[bj][0] * x1[bj][0] + x1[bj][1] * x1[bj][1]) + (x1[bj][2] * x1[bj][2] + x1[bj][3] * x1[bj][3]) + (x2[bj][0] * x2[bj][0] + x2[bj][1] * x2[bj][1]) + (x2[bj][2] * x2[bj][2] + x2[bj][3] * x2[bj][3]);
                    ss += __shfl_xor(ss, 16); ss += __shfl_xor(ss, 32);
                    const float rs = 1.0f / sqrtf(ss * (1.0f / 64.0f) + eps);
#pragma unroll
                    for (int bj = 0; bj < 2; ++bj) { x1[bj] = x1[bj] * rs * g1[bj]; x2[bj] = x2[bj] * rs * g2[bj]; } }
                if (dorope) {
#pragma unroll
                    for (int bj = 0; bj < 2; ++bj) { const f32x4 c = tc[m][bj], sn = ts[m][bj];
                        const f32x4 y1 = (x1[bj] * c - x2[bj] * sn) * sc, y2 = (x2[bj] * c + x1[bj] * sn) * sc; x1[bj] = y1; x2[bj] = y2; } }
                if (iskb) { float ss = 0.f;
#pragma unroll
                    for (int bj = 0; bj < 2; ++bj) ss += (x1[bj][0] * x1[bj][0] + x1[bj][1] * x1[bj][1]) + (x1[bj][2] * x1[bj][2] + x1[bj][3] * x1[bj][3]) + (x2[bj][0] * x2[bj][0] + x2[bj][1] * x2[bj][1]) + (x2[bj][2] * x2[bj][2] + x2[bj][3] * x2[bj][3]);
                    ss += __shfl_xor(ss, 16); ss += __shfl_xor(ss, 32); kss_max = fmaxf(kss_max, ss); }
                const int t = row & seqmask;
                unsigned char* dst;
                int kind;
                if (pn == 2) { const size_t hb = ((size_t)((row >> seqshift) * 2 + (wc & 1)) * 128 + (t >> 6)) * 8192; const int rr = t & 63;
                    if (wc < 2) { dst = kimg + hb + rr * 16; kind = 1; } else { dst = vimg + hb + rr * 64; kind = 2; } }
                else if (pn >= 3) { const int which = (pn - 3) >> 1, hh = ((pn - 3) & 1) * 4 + wc;
                    dst = (unsigned char*)(mbq + ((((size_t)which * 8 + (row >> seqshift)) * 8 + hh) * (size_t)(seqmask + 1) + t) * 64); kind = 0; }
                else { dst = (unsigned char*)(O + (size_t)row * ldc + pn * BM + wc * 64); kind = 0; }
#pragma unroll
                for (int bj = 0; bj < 2; ++bj) { u32x2 lo, hi2; lo.x = cvt_pk_bf16(x1[bj][0], x1[bj][1]); lo.y = cvt_pk_bf16(x1[bj][2], x1[bj][3]); hi2.x = cvt_pk_bf16(x2[bj][0], x2[bj][1]); hi2.y = cvt_pk_bf16(x2[bj][2], x2[bj][3]);
                    const auto rx = __builtin_amdgcn_permlane16_swap(hi2.x, lo.x, false, false), ry = __builtin_amdgcn_permlane16_swap(hi2.y, lo.y, false, false);
                    u32x4 w; w.x = rx[0]; w.y = ry[0]; w.z = rx[1]; w.w = ry[1];
                    const int c = col16 + 16 * bj;
                    unsigned char* p16 = (kind == 0) ? dst + c * 2 : (kind == 1) ? dst + (c >> 3) * 1024 : dst + (c >> 5) * 4096 + (c & 31) * 2;
                    *(u32x4*)p16 = w; } } }
        if (iskb) {
#pragma unroll
            for (int o_ = 1; o_ < 16; o_ <<= 1) kss_max = fmaxf(kss_max, __shfl_xor(kss_max, o_));
            if ((threadIdx.x & 63) == 0) atomicMax(kmax + ((u.pm * BM) >> seqshift) * 8 + (pn - 5) * 4 + wc, __float_as_uint(kss_max)); }
    }
};
struct EpiH {
    static constexpr bool PERM = true, MID = true;
    const float* base; bf16_t* HB; int ldc; const float* ssq; PG8_LAS float* scr; float eps;
    __device__ __forceinline__ void prep(const Unit& u, int par) const {
        const int tid = threadIdx.x;
        if (tid < 256) { const f32x2v q = *(const f32x2v*)(ssq + (size_t)(u.pm * BM + tid) * 2);
            const float rA = 1.0f / sqrtf(q.x * (1.0f / 512.0f) + eps), rB = 1.0f / sqrtf(q.y * (1.0f / 512.0f) + eps);
            scr[par * 512 + tid * 2] = rA / rB; scr[par * 512 + tid * 2 + 1] = rB; }
    }
    __device__ __forceinline__ void mid(f32x4 (&acc)[2][2][4][2], int par, int wr, int fr) const {
#pragma unroll
        for (int ai = 0; ai < 2; ++ai)
#pragma unroll
            for (int m = 0; m < 4; ++m) { const float f = scr[par * 512 + (ai * HALF + wr * 64 + m * 16 + fr) * 2];
#pragma unroll
                for (int bj = 0; bj < 2; ++bj)
#pragma unroll
                    for (int n = 0; n < 2; ++n) acc[ai][bj][m][n] = acc[ai][bj][m][n] * f; }
    }
    __device__ __forceinline__ void operator()(const f32x4 (&acc)[2][2][4][2], const Unit& u, int wr, int wc, int fr, int fq, int par) const {
        const int row0 = u.pm * BM + wr * 64 + fr, col0 = u.pn * BM + wc * 32 + 8 * fq;
#pragma unroll
        for (int ai = 0; ai < 2; ++ai) {
            f32x4 rb0[4][2], rb1[4][2];
#pragma unroll
            for (int m = 0; m < 4; ++m) { const size_t off = (size_t)(row0 + ai * HALF + m * 16) * ldc + col0;
#pragma unroll
                for (int bj = 0; bj < 2; ++bj) { rb0[m][bj] = *(const f32x4*)(base + off + bj * HALF); rb1[m][bj] = *(const f32x4*)(base + off + bj * HALF + 4); } }
#pragma unroll
            for (int m = 0; m < 4; ++m) { const size_t off = (size_t)(row0 + ai * HALF + m * 16) * ldc + col0; const float rB = scr[par * 512 + (ai * HALF + wr * 64 + m * 16 + fr) * 2 + 1];
#pragma unroll
                for (int bj = 0; bj < 2; ++bj) {
                    const f32x4 v0 = acc[ai][bj][m][0] * rB + rb0[m][bj], v1 = acc[ai][bj][m][1] * rB + rb1[m][bj];
                    u32x4 w; w.x = cvt_pk_bf16(v0[0], v0[1]); w.y = cvt_pk_bf16(v0[2], v0[3]); w.z = cvt_pk_bf16(v1[0], v1[1]); w.w = cvt_pk_bf16(v1[2], v1[3]);
                    *(u32x4*)(HB + off + bj * HALF) = w; } } }
    }
};
__device__ __forceinline__ float silu_f(float x) { return x * __builtin_amdgcn_rcpf(1.0f + __builtin_amdgcn_exp2f(-1.4426950408889634f * x)); }
struct EpiGU {
    static constexpr bool PERM = true, MID = false;
    bf16_t* HDN; const PG8_LAS float* rowt;
    __device__ __forceinline__ void operator()(const f32x4 (&acc)[2][2][4][2], const Unit& u, int wr, int wc, int fr, int fq, int par) const {
        const int pl = u.pn & 3;
#pragma unroll
        for (int ai = 0; ai < 2; ++ai)
#pragma unroll
            for (int m = 0; m < 4; ++m) { const int r = ai * HALF + wr * 64 + m * 16 + fr; const bool ok = r < u.nv;
                const float rs = rowt[par * 256 + r];
                bf16_t* rowp = HDN + (size_t)(u.pm * BM + r) * DEXP + pl * 128 + wc * 32 + 8 * fq;
                const f32x4 g0 = acc[ai][0][m][0] * rs, u0 = acc[ai][0][m][1] * rs, g1 = acc[ai][1][m][0] * rs, u1 = acc[ai][1][m][1] * rs;
                u32x4 w; w.x = cvt_pk_bf16(silu_f(g0[0]) * u0[0], silu_f(g0[1]) * u0[1]); w.y = cvt_pk_bf16(silu_f(g0[2]) * u0[2], silu_f(g0[3]) * u0[3]);
                w.z = cvt_pk_bf16(silu_f(g1[0]) * u1[0], silu_f(g1[1]) * u1[1]); w.w = cvt_pk_bf16(silu_f(g1[2]) * u1[2], silu_f(g1[3]) * u1[3]);
                *(u32x4*)rowp = w; }
    }
};
struct EpiDown {
    static constexpr bool PERM = true, MID = false;
    bf16_t* CON; const PG8_LAS int* tokt; const PG8_LAS float* rowt;
    __device__ __forceinline__ void operator()(const f32x4 (&acc)[2][2][4][2], const Unit& u, int wr, int wc, int fr, int fq, int par) const {
        const int pl = u.pn & 3;
        int slot[2][4]; float gt[2][4];
#pragma unroll
        for (int ai = 0; ai < 2; ++ai)
#pragma unroll
            for (int m = 0; m < 4; ++m) { const int r = ai * HALF + wr * 64 + m * 16 + fr; const int sl = tokt[par * 256 + r]; slot[ai][m] = (r < u.nv) ? sl : 2 * M; gt[ai][m] = rowt[par * 256 + r]; }
#pragma unroll
        for (int ai = 0; ai < 2; ++ai)
#pragma unroll
            for (int m = 0; m < 4; ++m) {
                bf16_t* rowp = CON + (size_t)slot[ai][m] * DM + pl * BM + wc * 32 + 8 * fq;
#pragma unroll
                for (int bj = 0; bj < 2; ++bj) { const f32x4 v0 = acc[ai][bj][m][0] * gt[ai][m], v1 = acc[ai][bj][m][1] * gt[ai][m];
                    u32x4 w; w.x = cvt_pk_bf16(v0[0], v0[1]); w.y = cvt_pk_bf16(v0[2], v0[3]); w.z = cvt_pk_bf16(v1[0], v1[1]); w.w = cvt_pk_bf16(v1[2], v1[3]);
                    *(u32x4*)(rowp + bj * HALF) = w; } }
    }
};

template <class Epi, class Sched, bool ALIGN_EPI = false>
__device__ __forceinline__ void gemm_phase(PG8_LAS unsigned char* lds, const Gemm g, const Sched& S, const Epi& E) {
    const int tid = threadIdx.x, wid = __builtin_amdgcn_readfirstlane(tid >> 6), lane = tid & 63, wr = wid >> 2, wc = wid & 3, fr = lane & 15, fq = lane >> 4;
    const int K = g.K, nt = K / BK;
    int Rr[2], Cc[2]; unsigned voffB[2];
#pragma unroll
    for (int i = 0; i < 2; ++i) { int R, C; stage_rc(tid * 16 + i * 8192, R, C); const int Rb = Epi::PERM ? ((R & ~31) + perm32(R & 31)) : R;
        Rr[i] = R; Cc[i] = C; voffB[i] = (unsigned)(Rb * K + C) * 2u; }
    const size_t kstep = (size_t)(BK * 2);
    const size_t hstep = (size_t)HALF * K * 2;
    const size_t tstep = 2 * hstep;
    const unsigned ldsw = (unsigned)wid * 1024u;
    const int aoff = lds_byte(wr * 64 + fr, fq * 8), boff = lds_byte(wc * 32 + fr, fq * 8);
#define PG8_SA(b, h) (((b) * 2 + (h)) * HTB)
#define PG8_SB(b, h) ((4 + (b) * 2 + (h)) * HTB)
#define PG8_STAGE(bufoff, gbase, voff) do { _Pragma("unroll") for (int _i = 0; _i < 2; ++_i) \
        __builtin_amdgcn_global_load_lds((const unsigned*)((const char*)(gbase) + (voff)[_i]), (PG8_LAS unsigned*)(lds + (bufoff) + ldsw + _i * 8192), 16, 0, 0); } while (0)
#define PG8_LDA(dst, b, h) do { _Pragma("unroll") for (int m = 0; m < 4; ++m) _Pragma("unroll") for (int k = 0; k < 2; ++k) dst[m][k] = *(const PG8_LAS bf16x8*)(lds + PG8_SA(b, h) + aoff + m * 2048 + k * 1024); } while (0)
#define PG8_LDB(dst, b, h) do { _Pragma("unroll") for (int n = 0; n < 2; ++n) _Pragma("unroll") for (int k = 0; k < 2; ++k) dst[n][k] = *(const PG8_LAS bf16x8*)(lds + PG8_SB(b, h) + boff + n * 2048 + k * 1024); } while (0)
#define PG8_MMA(ai, bj, At, Bt) do { __builtin_amdgcn_s_setprio(1); _Pragma("unroll") for (int m = 0; m < 4; ++m) _Pragma("unroll") for (int n = 0; n < 2; ++n) _Pragma("unroll") for (int k = 0; k < 2; ++k) \
        acc[ai][bj][m][n] = __builtin_amdgcn_mfma_f32_16x16x32_bf16(Bt[n][k], At[m][k], acc[ai][bj][m][n], 0, 0, 0); __builtin_amdgcn_s_setprio(0); } while (0)
#define PG8_WAIT_V(n) asm volatile("s_waitcnt vmcnt(" #n ")" ::: "memory")
#define PG8_WAIT_L(n) asm volatile("s_waitcnt lgkmcnt(" #n ")" ::: "memory")
#define PG8_BAR __builtin_amdgcn_s_barrier()
#define PG8_SCHED __builtin_amdgcn_sched_barrier(0)
    Unit cur, nxt; int ui = 0;
    if (!S.next(0, cur)) return;
    f32x4 acc[2][2][4][2];
#pragma unroll
    for (int a = 0; a < 2; ++a)
#pragma unroll
        for (int b = 0; b < 2; ++b)
#pragma unroll
            for (int m = 0; m < 4; ++m)
#pragma unroll
                for (int n = 0; n < 2; ++n) acc[a][b][m][n] = (f32x4){0.f, 0.f, 0.f, 0.f};
    bf16x8 At[4][2], B0[2][2], B1[2][2];
    unsigned vA[2][2], nvA[2][2];
    if constexpr (Sched::FETCH) { S.fetch(cur, 0); PG8_WAIT_V(0); PG8_BAR; }
#pragma unroll
    for (int h = 0; h < 2; ++h)
#pragma unroll
        for (int i = 0; i < 2; ++i) vA[h][i] = Sched::GATHER ? S.row_off(cur, h * HALF + Rr[i], 0) + (unsigned)Cc[i] * 2u : (unsigned)((h * HALF + Rr[i]) * K + Cc[i]) * 2u;
    const char* cA = Sched::GATHER ? (const char*)g.A : (const char*)g.A + (size_t)cur.pm * tstep; const char* cB = (const char*)g.Bt + (size_t)cur.pn * tstep;
    if constexpr (Epi::MID) E.prep(cur, 0);
    PG8_STAGE(PG8_SB(0, 0), cB, voffB); PG8_STAGE(PG8_SB(0, 1), cB + hstep, voffB); PG8_STAGE(PG8_SA(0, 0), cA, vA[0]); PG8_STAGE(PG8_SA(0, 1), cA, vA[1]);
    if (wr == 1) PG8_BAR;
    PG8_WAIT_V(2); PG8_BAR;
    PG8_STAGE(PG8_SB(1, 0), cB + kstep, voffB); PG8_STAGE(PG8_SA(1, 0), cA + kstep, vA[0]); PG8_STAGE(PG8_SB(1, 1), cB + hstep + kstep, voffB);
    PG8_WAIT_V(6); PG8_BAR;
    for (;;) {
        const bool has_next = S.next(ui + 1, nxt);
        const char* nA = has_next ? (Sched::GATHER ? (const char*)g.A : (const char*)g.A + (size_t)nxt.pm * tstep) : cA; const char* nB = has_next ? (const char*)g.Bt + (size_t)nxt.pn * tstep : cB;
        if constexpr (Sched::FETCH) { if (has_next) S.fetch(nxt, (ui + 1) % 3); }
#pragma unroll
        for (int h = 0; h < 2; ++h)
#pragma unroll
            for (int i = 0; i < 2; ++i) nvA[h][i] = vA[h][i];
        for (int t = 0; t < nt; t += 2) {
            const bool last = (t == nt - 2);
            if constexpr (Sched::GATHER) { if (last && has_next) {
#pragma unroll
                for (int h = 0; h < 2; ++h)
#pragma unroll
                    for (int i = 0; i < 2; ++i) nvA[h][i] = S.row_off(nxt, h * HALF + Rr[i], (ui + 1) % 3) + (unsigned)Cc[i] * 2u; } }
            if constexpr (Epi::MID) { if (t == nt / 2) E.mid(acc, ui & 1, wr, fr); }
            const char* a1 = cA + (size_t)(t + 1) * kstep;
            const char* a2 = last ? nA : cA + (size_t)(t + 2) * kstep; const char* b2 = last ? nB : cB + (size_t)(t + 2) * kstep;
            const char* a3 = a2 + kstep; const char* b3 = b2 + kstep;
            unsigned o2[2][2];
#pragma unroll
            for (int h = 0; h < 2; ++h)
#pragma unroll
                for (int i = 0; i < 2; ++i) o2[h][i] = last ? nvA[h][i] : vA[h][i];
            PG8_LDB(B0, 0, 0); PG8_LDB(B1, 0, 1); PG8_SCHED; PG8_LDA(At, 0, 0); PG8_STAGE(PG8_SA(1, 1), a1, vA[1]);
            PG8_WAIT_V(8); PG8_WAIT_L(0); PG8_BAR; PG8_MMA(0, 0, At, B0); PG8_MMA(0, 1, At, B1); PG8_BAR; PG8_SCHED;
            PG8_LDA(At, 0, 1); PG8_STAGE(PG8_SB(0, 0), b2, voffB); PG8_STAGE(PG8_SB(0, 1), b2 + hstep, voffB); PG8_STAGE(PG8_SA(0, 0), a2, o2[0]);
            PG8_WAIT_V(8); PG8_WAIT_L(0); PG8_BAR; PG8_MMA(1, 0, At, B0); PG8_MMA(1, 1, At, B1); PG8_BAR; PG8_SCHED;
            PG8_LDB(B0, 1, 0); PG8_LDB(B1, 1, 1); PG8_SCHED; PG8_LDA(At, 1, 0); PG8_STAGE(PG8_SA(0, 1), a2, o2[1]);
            PG8_WAIT_V(8); PG8_WAIT_L(0); PG8_BAR; PG8_MMA(0, 0, At, B0); PG8_MMA(0, 1, At, B1); PG8_BAR; PG8_SCHED;
            PG8_LDA(At, 1, 1); PG8_STAGE(PG8_SB(1, 0), b3, voffB); PG8_STAGE(PG8_SB(1, 1), b3 + hstep, voffB); PG8_STAGE(PG8_SA(1, 0), a3, o2[0]);
            PG8_WAIT_V(8); PG8_WAIT_L(0); PG8_BAR; PG8_MMA(1, 0, At, B0); PG8_MMA(1, 1, At, B1); PG8_BAR; PG8_SCHED;
        }
        if constexpr (ALIGN_EPI) { if (wr == 0) PG8_BAR; }
        if constexpr (Epi::MID) { E(acc, cur, wr, wc, fr, fq, ui & 1); if (has_next) E.prep(nxt, (ui + 1) & 1); }
        else if constexpr (Sched::FETCH) E(acc, cur, wr, wc, fr, fq, ui % 3);
        else E(acc, cur, wr, wc, fr, fq);
        if (!has_next) break;
#pragma unroll
        for (int a = 0; a < 2; ++a)
#pragma unroll
            for (int b = 0; b < 2; ++b)
#pragma unroll
                for (int m = 0; m < 4; ++m)
#pragma unroll
                    for (int n = 0; n < 2; ++n) acc[a][b][m][n] = (f32x4){0.f, 0.f, 0.f, 0.f};
        cur = nxt; cA = nA; cB = nB; ++ui;
#pragma unroll
        for (int h = 0; h < 2; ++h)
#pragma unroll
            for (int i = 0; i < 2; ++i) vA[h][i] = nvA[h][i];
        if constexpr (ALIGN_EPI) { if (wr == 1) PG8_BAR; }
    }
    PG8_WAIT_V(0);
    if constexpr (!ALIGN_EPI) { if (wr == 0) PG8_BAR; }
    PG8_BAR;
#undef PG8_SA
#undef PG8_SB
#undef PG8_STAGE
#undef PG8_LDA
#undef PG8_LDB
#undef PG8_MMA
#undef PG8_WAIT_V
#undef PG8_WAIT_L
#undef PG8_BAR
#undef PG8_SCHED
}
}

namespace attn_body {
using bf16 = __hip_bfloat16;
using bf16x8 = __attribute__((ext_vector_type(8))) short;
using s16x4 = __attribute__((ext_vector_type(4))) short;
using f32x16 = __attribute__((ext_vector_type(16))) float;
using u32x4 = __attribute__((ext_vector_type(4))) unsigned;
constexpr int D = 64;
constexpr int NW = 8, QBLK = 32, QB = QBLK * NW, KVBLK = 64;
__device__ __forceinline__ int crow(int r, int hi) { return (r & 3) + 8 * (r >> 2) + 4 * hi; }
#define SBAR() __builtin_amdgcn_sched_barrier(0)
constexpr int NSLOT = 3, SLOTB = 8192;
constexpr int LDS_K = 0, LDS_V = NSLOT * SLOTB, LDS_WS = 2 * NSLOT * SLOTB, LDS_OST = LDS_WS + NW * 64 * 4, LDS_BYTES = LDS_OST + NW * 4096;
__device__ __forceinline__ void glds16(const void* gsrc, unsigned lds_dst) { unsigned keep;
  asm volatile("s_mov_b32 %0, m0\n\ts_mov_b32 m0, %2\n\ts_nop 0\n\tglobal_load_lds_dwordx4 %1, off\n\ts_mov_b32 m0, %0" : "=&s"(keep) : "v"(gsrc), "s"(lds_dst) : "memory"); }
__device__ __forceinline__ float max3f(float a, float b, float c) { float r; asm("v_max3_f32 %0, %1, %2, %3" : "=v"(r) : "v"(a), "v"(b), "v"(c)); return r; }
__device__ __forceinline__ float max2f(float a, float b) { float r; asm("v_max_f32_e32 %0, %1, %2" : "=v"(r) : "v"(a), "v"(b)); return r; }
__device__ __forceinline__ float fadd_s(float a, float b) { float r; asm("v_add_f32_e32 %0, %1, %2" : "=v"(r) : "v"(a), "v"(b)); return r; }
__device__ __forceinline__ float fsub_s(float a, float b) { float r; asm("v_sub_f32_e32 %0, %1, %2" : "=v"(r) : "v"(a), "v"(b)); return r; }
typedef float f32x2_t __attribute__((ext_vector_type(2))); typedef __bf16 bf16x2_t __attribute__((ext_vector_type(2)));
__device__ __forceinline__ unsigned cvtpk_s(float lo, float hi) { f32x2_t v = {lo, hi}; bf16x2_t b = __builtin_convertvector(v, bf16x2_t); return __builtin_bit_cast(unsigned, b); }
#define WAIT_BAR(N) asm volatile("s_waitcnt vmcnt(" #N ") lgkmcnt(0)\n\ts_barrier" ::: "memory")

__device__ __forceinline__ void qkt(f32x16& p0, f32x16& p1, const char* Kslot, const bf16x8* qr, const f32x16& negm, int r32, int hi) {
  const char* kb = Kslot + hi * 1024 + r32 * 16;
  #pragma unroll
  for (int d0 = 0; d0 < 4; ++d0) {
    const bf16x8 b0 = *reinterpret_cast<const bf16x8*>(kb + d0 * 2048);
    const bf16x8 b1 = *reinterpret_cast<const bf16x8*>(kb + d0 * 2048 + 512);
    if (d0 == 0) { p0 = __builtin_amdgcn_mfma_f32_32x32x16_bf16(b0, qr[0], negm, 0, 0, 0); p1 = __builtin_amdgcn_mfma_f32_32x32x16_bf16(b1, qr[0], negm, 0, 0, 0); }
    else { p0 = __builtin_amdgcn_mfma_f32_32x32x16_bf16(b0, qr[d0], p0, 0, 0, 0); p1 = __builtin_amdgcn_mfma_f32_32x32x16_bf16(b1, qr[d0], p1, 0, 0, 0); } }
}
typedef __attribute__((address_space(3))) const char* lds_cptr;
typedef short v4i16_t __attribute__((ext_vector_type(4)));
__device__ __forceinline__ void kload8(bf16x8* kf, lds_cptr kp) {
  kf[0] = *(const __attribute__((address_space(3))) bf16x8*)(kp);        kf[1] = *(const __attribute__((address_space(3))) bf16x8*)(kp + 512);
  kf[2] = *(const __attribute__((address_space(3))) bf16x8*)(kp + 2048); kf[3] = *(const __attribute__((address_space(3))) bf16x8*)(kp + 2560);
  kf[4] = *(const __attribute__((address_space(3))) bf16x8*)(kp + 4096); kf[5] = *(const __attribute__((address_space(3))) bf16x8*)(kp + 4608);
  kf[6] = *(const __attribute__((address_space(3))) bf16x8*)(kp + 6144); kf[7] = *(const __attribute__((address_space(3))) bf16x8*)(kp + 6656);
}
__device__ __forceinline__ void kload2(bf16x8* kf, lds_cptr kp, int j) { kf[2 * j] = *(const __attribute__((address_space(3))) bf16x8*)(kp + j * 2048); kf[2 * j + 1] = *(const __attribute__((address_space(3))) bf16x8*)(kp + j * 2048 + 512); }
__device__ __forceinline__ s16x4 vtr(lds_cptr p) { return __builtin_bit_cast(s16x4, __builtin_amdgcn_ds_read_tr16_b64_v4i16((__attribute__((address_space(3))) v4i16_t*)p)); }
__device__ __forceinline__ float rowmax(const f32x16& p0, const f32x16& p1) {
  float a = max3f(p0[0], p0[1], p1[0]), b = max3f(p0[2], p0[3], p1[1]); a = max3f(a, p1[2], p1[3]);
  #pragma unroll
  for (int r = 4; r < 16; r += 4) { a = max3f(a, p0[r], p0[r + 1]); b = max3f(b, p0[r + 2], p0[r + 3]); a = max3f(a, p1[r], p1[r + 1]); b = max3f(b, p1[r + 2], p1[r + 3]); }
  const float m = max2f(a, b);
  auto rr = __builtin_amdgcn_permlane32_swap(__float_as_uint(m), __float_as_uint(m), false, false);
  return max2f(__uint_as_float(rr[0]), __uint_as_float(rr[1]));
}
__device__ __forceinline__ void pv(f32x16* o, int vb, bf16x8 pa0, bf16x8 pa1, bf16x8 pa2, bf16x8 pa3) {
  #pragma unroll
  for (int d0 = 0; d0 < 2; ++d0) { s16x4 lo[4], hi[4];
    #pragma unroll
    for (int ks = 0; ks < 4; ++ks) {
      asm volatile("ds_read_b64_tr_b16 %0,%1 offset:%c2" : "=&v"(lo[ks]) : "v"(vb), "i"(d0 * 4096 + ks * 1024) : "memory");
      asm volatile("ds_read_b64_tr_b16 %0,%1 offset:%c2" : "=&v"(hi[ks]) : "v"(vb), "i"(d0 * 4096 + ks * 1024 + 512) : "memory"); }
    asm volatile("s_waitcnt lgkmcnt(0)" ::: "memory"); SBAR();
    #define PK(k) (bf16x8){lo[k][0], lo[k][1], lo[k][2], lo[k][3], hi[k][0], hi[k][1], hi[k][2], hi[k][3]}
    o[d0] = __builtin_amdgcn_mfma_f32_32x32x16_bf16(pa0, PK(0), o[d0], 0, 0, 0);
    o[d0] = __builtin_amdgcn_mfma_f32_32x32x16_bf16(pa1, PK(1), o[d0], 0, 0, 0);
    o[d0] = __builtin_amdgcn_mfma_f32_32x32x16_bf16(pa2, PK(2), o[d0], 0, 0, 0);
    o[d0] = __builtin_amdgcn_mfma_f32_32x32x16_bf16(pa3, PK(3), o[d0], 0, 0, 0);
    #undef PK
  }
}

#define ATTN_STORE16(p, v) (*(u32x4*)(p) = (v))
template <int THRL, int QP, int KP, int VP, int OP> __device__ __forceinline__ void attn_unit(const bf16* Qw0, const bf16* __restrict__ Kh, const bf16* __restrict__ Vh, bf16* Ow0, float* ssq0, const bool FIXREF  , float sref, int NT, char* shm) {
  const int tid = threadIdx.x, lane = tid & 63, r32 = lane & 31, hi = lane >> 5; const int wid = __builtin_amdgcn_readfirstlane(tid >> 6);
  const bf16* Qw = Qw0 + (long)(wid * QBLK) * QP;
  const unsigned lds0 = (unsigned)(uintptr_t)shm;
  float* wsf = (float*)(shm + LDS_WS) + wid * 64;
  const bf16* ksrc = (KP == 0) ? Kh + wid * 512 + lane * 8 : Kh + (long)lane * KP + wid * 8;
  const bf16* vsrc = (KP == 0) ? Vh + wid * 512 + lane * 8 : Vh + (long)(16 * (wid & 3) + (lane >> 2)) * VP + (wid >> 2) * 32 + (lane & 3) * 8;
  const unsigned kdst = lds0 + LDS_K + wid * 1024, vdst = lds0 + LDS_V + wid * 1024;
  #define DMA_K(t, slot) glds16(ksrc + (long)(t) * ((KP == 0) ? 4096 : KVBLK * KP), (unsigned)__builtin_amdgcn_readfirstlane(kdst + (slot)))
  #define DMA_V(t, slot) glds16(vsrc + (long)(t) * ((VP == 0) ? 4096 : KVBLK * VP), (unsigned)__builtin_amdgcn_readfirstlane(vdst + (slot)))
  const int vb0 = (int)(lds0 + LDS_V) + ((lane >> 4) & 1) * 32 + (lane & 3) * 8 + (4 * hi + ((lane & 15) >> 2)) * 64;
  const char* Kbase = shm + LDS_K; bf16x8 kf[8];
  const lds_cptr shm3 = (lds_cptr)shm; const lds_cptr kp0 = shm3 + LDS_K + hi * 1024 + r32 * 16; const lds_cptr vp0 = shm3 + LDS_V + ((lane >> 4) & 1) * 32 + (lane & 3) * 8 + (4 * hi + ((lane & 15) >> 2)) * 64;
  DMA_K(0, 0); DMA_V(0, 0); DMA_K(1, SLOTB);
  bf16x8 qr[4];
  #pragma unroll
  for (int d0 = 0; d0 < 4; ++d0) qr[d0] = *reinterpret_cast<const bf16x8*>(&Qw[(long)r32 * QP + d0 * 16 + hi * 8]);
  float mhat = 0.f, l_reg = 0.f; f32x16 o[2]; o[0] = f32x16{}; o[1] = f32x16{}; f32x16 negm = f32x16{};
  if (FIXREF) { _Pragma("unroll") for (int r = 0; r < 16; ++r) negm[r] = -sref; }
  asm volatile("" : "+v"(negm));
  bool resc = false;
  #define START(P0, P1) do { resc = false; \
    if (!FIXREF) { const float rm = rowmax(P0, P1); const float dl = rm; mhat = fadd_s(mhat, dl); \
      _Pragma("unroll") for (int r = 0; r < 16; ++r) { P0[r] = fsub_s(P0[r], dl); P1[r] = fsub_s(P1[r], dl); } \
      _Pragma("unroll") for (int r = 0; r < 16; ++r) negm[r] = -mhat; asm volatile("" : "+v"(negm)); } \
    _Pragma("unroll") for (int r = 0; r < 16; ++r) P0[r] = __builtin_amdgcn_exp2f(P0[r]); } while (0)
  #define RESC() do { if (!FIXREF && resc) { asm volatile("s_waitcnt lgkmcnt(0)" ::: "memory"); \
      _Pragma("unroll") for (int d_ = 0; d_ < 2; ++d_) _Pragma("unroll") for (int r = 0; r < 16; ++r) o[d_][r] *= wsf[crow(r, hi)]; } } while (0)
  f32x16 pA0, pA1, pB0, pB1;
  int sl_prev = 0, sl_cur = 0, sl_next = SLOTB;
  #define ROT() do { sl_prev = sl_cur; sl_cur = sl_next; sl_next = (sl_next == (NSLOT - 1) * SLOTB) ? 0 : sl_next + SLOTB; } while (0)
  DMA_K(2, 2 * SLOTB);
  WAIT_BAR(3);
  qkt(pA0, pA1, Kbase, qr, negm, r32, hi); asm volatile("s_nop 15\n\ts_nop 7" : "+v"(pA0), "+v"(pA1));
  START(pA0, pA1);
  _Pragma("unroll") for (int r = 0; r < 16; ++r) pA1[r] = __builtin_amdgcn_exp2f(pA1[r]);
  WAIT_BAR(0);
  DMA_K(3, 0); DMA_V(1, SLOTB);
  ROT();
  kload8(kf, kp0 + sl_cur);
  WAIT_BAR(2);
  s16x4 vlo[8], vhi[8]; u32x4 pw0, pw1, pw2, pw3;
  #define PKW(P, B) cvtpk_s(P[B], P[B + 1])
  #define PAF(k) __builtin_bit_cast(bf16x8, pw##k)
  #define VFR(i) (bf16x8){vlo[i][0], vlo[i][1], vlo[i][2], vlo[i][3], vhi[i][0], vhi[i][1], vhi[i][2], vhi[i][3]}
  #define PIN(x) asm volatile("" : "+v"(x))
  #define MX3(a, b, c) __builtin_fmaxf(__builtin_fmaxf((a), (b)), (c))
  #define GAPA(MF, A0, A1, A2, A3, W0, W1, PW) do { MF; sacc += A0; sacc += A1; sacc += A2; sacc += A3; PIN(sacc); W0; W1; PIN(PW); SBAR(); } while (0)
  #define EX(v) __builtin_amdgcn_exp2f(v)
  #define GAPB(MF, X, B) do { MF; X[B] = EX(X[B]); X[B + 1] = EX(X[B + 1]); X[B + 2] = EX(X[B + 2]); X[B + 3] = EX(X[B + 3]); PIN(X); SBAR(); } while (0)
  #define VRD(i) do { vlo[i] = vtr(vp_ + (((i) >> 2) * 4096 + ((i) & 3) * 1024)); vhi[i] = vtr(vp_ + (((i) >> 2) * 4096 + ((i) & 3) * 1024 + 512)); } while (0)
  #define KRD(G, j) do { if (G) { kload2(kf, kp0 + sl_next, j); SBAR(); } } while (0)
  #define STEP(C0, C1, P0, P1, t, GK, GV, GL) do { SBAR(); \
    const lds_cptr vp_ = vp0 + sl_prev; \
    VRD(0); SBAR(); float sacc = (P0[0] + P0[1]); \
    GAPA(C0 = __builtin_amdgcn_mfma_f32_32x32x16_bf16(kf[0], qr[0], negm, 0, 0, 0), P0[2], P0[3], P0[4], P0[5],     pw0[0] = PKW(P0, 0), pw0[1] = PKW(P0, 2), pw0); \
    VRD(4); SBAR(); GAPA(C1 = __builtin_amdgcn_mfma_f32_32x32x16_bf16(kf[1], qr[0], negm, 0, 0, 0), P0[6], P0[7], P0[8], P0[9],     pw0[2] = PKW(P0, 4), pw0[3] = PKW(P0, 6), pw0); \
    VRD(1); SBAR(); GAPA(C0 = __builtin_amdgcn_mfma_f32_32x32x16_bf16(kf[2], qr[1], C0, 0, 0, 0),   P0[10], P0[11], P0[12], P0[13], pw1[0] = PKW(P0, 8), pw1[1] = PKW(P0, 10), pw1); \
    VRD(5); SBAR(); GAPA(C1 = __builtin_amdgcn_mfma_f32_32x32x16_bf16(kf[3], qr[1], C1, 0, 0, 0),   P0[14], P0[15], P1[0], P1[1],   pw1[2] = PKW(P0, 12), pw1[3] = PKW(P0, 14), pw1); \
    VRD(2); SBAR(); GAPA(C0 = __builtin_amdgcn_mfma_f32_32x32x16_bf16(kf[4], qr[2], C0, 0, 0, 0),   P1[2], P1[3], P1[4], P1[5],     pw2[0] = PKW(P1, 0), pw2[1] = PKW(P1, 2), pw2); \
    VRD(6); SBAR(); GAPA(C1 = __builtin_amdgcn_mfma_f32_32x32x16_bf16(kf[5], qr[2], C1, 0, 0, 0),   P1[6], P1[7], P1[8], P1[9],     pw2[2] = PKW(P1, 4), pw2[3] = PKW(P1, 6), pw2); \
    VRD(3); SBAR(); GAPA(C0 = __builtin_amdgcn_mfma_f32_32x32x16_bf16(kf[6], qr[3], C0, 0, 0, 0),   P1[10], P1[11], P1[12], P1[13], pw3[0] = PKW(P1, 8), pw3[1] = PKW(P1, 10), pw3); \
    VRD(7); SBAR(); GAPA(C1 = __builtin_amdgcn_mfma_f32_32x32x16_bf16(kf[7], qr[3], C1, 0, 0, 0),   P1[14], P1[15], 0.f, 0.f,       pw3[2] = PKW(P1, 12), pw3[3] = PKW(P1, 14), pw3); \
    l_reg += sacc; \
    if (GK) { DMA_K((t) + 3, sl_cur); } if (GV) { DMA_V((t) + 1, sl_next); } \
    if (!FIXREF) { float a = MX3(C0[0], C0[1], C1[0]), b = MX3(C0[2], C0[3], C1[1]); a = MX3(a, C1[2], C1[3]); \
      _Pragma("unroll") for (int r = 4; r < 16; r += 4) { a = MX3(a, C0[r], C0[r + 1]); b = MX3(b, C0[r + 2], C0[r + 3]); a = MX3(a, C1[r], C1[r + 1]); b = MX3(b, C1[r + 2], C1[r + 3]); } \
      float rm = __builtin_fmaxf(a, b); { auto rr = __builtin_amdgcn_permlane32_swap(__float_as_uint(rm), __float_as_uint(rm), false, false); rm = __builtin_fmaxf(__uint_as_float(rr[0]), __uint_as_float(rr[1])); } \
      resc = false; \
      if (__builtin_expect(__any(rm > (float)THRL), 0)) { const float dl = __builtin_fmaxf(rm, 0.f); mhat += dl; \
        _Pragma("unroll") for (int r = 0; r < 16; ++r) { C0[r] -= dl; C1[r] -= dl; } \
        _Pragma("unroll") for (int r = 0; r < 16; ++r) negm[r] = -mhat; asm volatile("" : "+v"(negm)); \
        const float f = __builtin_amdgcn_exp2f(-dl); l_reg *= f; if (hi == 0) wsf[r32] = f; resc = true; } } \
    SBAR(); \
    GAPB(o[0] = __builtin_amdgcn_mfma_f32_32x32x16_bf16(PAF(0), VFR(0), o[0], 0, 0, 0), C0, 0); \
    GAPB(o[1] = __builtin_amdgcn_mfma_f32_32x32x16_bf16(PAF(0), VFR(4), o[1], 0, 0, 0), C0, 4); \
    KRD(GL, 0); GAPB(o[0] = __builtin_amdgcn_mfma_f32_32x32x16_bf16(PAF(1), VFR(1), o[0], 0, 0, 0), C0, 8); \
    KRD(GL, 1); GAPB(o[1] = __builtin_amdgcn_mfma_f32_32x32x16_bf16(PAF(1), VFR(5), o[1], 0, 0, 0), C0, 12); \
    KRD(GL, 2); GAPB(o[0] = __builtin_amdgcn_mfma_f32_32x32x16_bf16(PAF(2), VFR(2), o[0], 0, 0, 0), C1, 0); \
    KRD(GL, 3); GAPB(o[1] = __builtin_amdgcn_mfma_f32_32x32x16_bf16(PAF(2), VFR(6), o[1], 0, 0, 0), C1, 4); \
    GAPB(o[0] = __builtin_amdgcn_mfma_f32_32x32x16_bf16(PAF(3), VFR(3), o[0], 0, 0, 0), C1, 8); \
    GAPB(o[1] = __builtin_amdgcn_mfma_f32_32x32x16_bf16(PAF(3), VFR(7), o[1], 0, 0, 0), C1, 12); \
    } while (0)
  int t = 1;
  for (; t + 5 < NT; t += 2) {
    STEP(pB0, pB1, pA0, pA1, t, true, true, true);     WAIT_BAR(2); RESC(); ROT();
    STEP(pA0, pA1, pB0, pB1, t + 1, true, true, true); WAIT_BAR(2); RESC(); ROT();
  }
  #define ENDW(tt) do { if ((tt) + 3 < NT) { WAIT_BAR(2); } else if ((tt) + 2 < NT) { WAIT_BAR(1); } else { WAIT_BAR(0); } } while (0)
  for (; t + 1 < NT; t += 2) {
    STEP(pB0, pB1, pA0, pA1, t, (t + 3 < NT), (t + 1 < NT), (t + 1 < NT));         ENDW(t);     RESC(); ROT();
    STEP(pA0, pA1, pB0, pB1, t + 1, (t + 4 < NT), (t + 2 < NT), (t + 2 < NT));     ENDW(t + 1); RESC(); ROT();
  }
  STEP(pB0, pB1, pA0, pA1, NT - 1, false, false, false); RESC();
  { float sacc = pB0[0] + pB0[1]; _Pragma("unroll") for (int r = 2; r < 16; ++r) sacc += pB0[r]; _Pragma("unroll") for (int r = 0; r < 16; ++r) sacc += pB1[r]; l_reg += sacc;
    pw0 = (u32x4){PKW(pB0, 0), PKW(pB0, 2), PKW(pB0, 4), PKW(pB0, 6)}; pw1 = (u32x4){PKW(pB0, 8), PKW(pB0, 10), PKW(pB0, 12), PKW(pB0, 14)}; pw2 = (u32x4){PKW(pB1, 0), PKW(pB1, 2), PKW(pB1, 4), PKW(pB1, 6)}; pw3 = (u32x4){PKW(pB1, 8), PKW(pB1, 10), PKW(pB1, 12), PKW(pB1, 14)};
    SBAR(); pv(o, vb0 + sl_cur, PAF(0), PAF(1), PAF(2), PAF(3)); }
  #undef PKW
  #undef PAF
  #undef VFR
  #undef PIN
  #undef MX3
  #undef GAPA
  #undef GAPB
  #undef EX
  #undef VRD
  #undef KRD
  #undef STEP
  #undef ENDW
  { auto rr = __builtin_amdgcn_permlane32_swap(__float_as_uint(l_reg), __float_as_uint(l_reg), false, false); l_reg = __uint_as_float(rr[0]) + __uint_as_float(rr[1]); }
  if (hi == 0) wsf[32 + r32] = l_reg; asm volatile("s_waitcnt lgkmcnt(0)" ::: "memory");
  float rli[16];
  #pragma unroll
  for (int r = 0; r < 16; ++r) rli[r] = __builtin_amdgcn_rcpf(wsf[32 + crow(r, hi)]);
  bf16* Ow = Ow0 + (long)(wid * QBLK) * OP;
  { bf16* stg = (bf16*)(shm + LDS_OST) + wid * 2048;
    #pragma unroll
    for (int r = 0; r < 16; ++r) { const int orow = crow(r, hi);
      #pragma unroll
      for (int d0 = 0; d0 < 2; ++d0) stg[orow * 64 + d0 * 32 + r32] = __float2bfloat16(o[d0][r] * rli[r]); }
    asm volatile("s_waitcnt lgkmcnt(0)" ::: "memory");
    #pragma unroll
    for (int i = 0; i < 4; ++i) { const int row = i * 8 + (lane >> 3), ch = lane & 7; const u32x4 v = *(const u32x4*)(stg + row * 64 + ch * 8); ATTN_STORE16(Ow + (long)row * OP + ch * 8, v);
      float sq = 0.f;
      #pragma unroll
      for (int j = 0; j < 4; ++j) { const float a = __uint_as_float(v[j] << 16), b = __uint_as_float(v[j] & 0xffff0000u); sq += a * a + b * b; }
      sq += __shfl_xor(sq, 1); sq += __shfl_xor(sq, 2); sq += __shfl_xor(sq, 4);
      if (ch == 0) atomicAdd(ssq0 + (wid * QBLK + row) * 2, sq); } }
  asm volatile("s_waitcnt lgkmcnt(0)\n\ts_barrier" ::: "memory");
  #undef DMA_K
  #undef DMA_V
  #undef START
  #undef RESC
  #undef ROT
}

#define MB_THR 8.0f
#define MB_NEG -1e30f
#define MB_ROWOFF(pos_) ((unsigned)((((pos_) < 0 ? 0 : ((pos_) >= Lsub ? Lsub - 1 : (pos_))) << dlsh) + res) * (unsigned)(P * 2))
#define MB_LOADK(KF, kt_) do { const unsigned ko_ = MB_ROWOFF(kstart + 32 * (kt_) + r32) + (unsigned)hi * 16u; \
    _Pragma("unroll") for (int d0 = 0; d0 < 4; ++d0) KF[d0] = *reinterpret_cast<const bf16x8*>((const char*)Kh + ko_ + d0 * 32); } while (0)
#define MB_LOADV(VV, kt_) do { const int kq0_ = kstart + 32 * (kt_); \
    _Pragma("unroll") for (int i = 0; i < 4; ++i) { const int c_ = i * 64 + lane, key_ = c_ >> 3, piece_ = c_ & 7; \
        VV[i] = *reinterpret_cast<const u32x4*>((const char*)Vh + MB_ROWOFF(kq0_ + key_) + (unsigned)piece_ * 16u); } } while (0)
#define MB_TILE(KF, KN, VF, VN, kt_) do { const int kp0_ = kstart + 32 * (kt_); \
    MB_LOADV(VN, (kt_) + 1); MB_LOADK(KN, (kt_) + 1); \
    f32x16 p = __builtin_amdgcn_mfma_f32_32x32x16_bf16(KF[0], qr[0], negm, 0, 0, 0); \
    p = __builtin_amdgcn_mfma_f32_32x32x16_bf16(KF[1], qr[1], p, 0, 0, 0); p = __builtin_amdgcn_mfma_f32_32x32x16_bf16(KF[2], qr[2], p, 0, 0, 0); p = __builtin_amdgcn_mfma_f32_32x32x16_bf16(KF[3], qr[3], p, 0, 0, 0); \
    const bool edge_ = (kp0_ < 0) || (kp0_ + 32 > Lsub); \
    if (edge_) { const int b0_ = kp0_ - qpos + 4 * hi + 64; \
        _Pragma("unroll") for (int r = 0; r < 16; ++r) { const int cr_ = (r & 3) + 8 * (r >> 2); \
            const bool ok_ = ((unsigned)(b0_ + cr_) <= 128u) && ((unsigned)(kp0_ + 4 * hi + cr_) < (unsigned)Lsub); p[r] = ok_ ? p[r] : MB_NEG; } } \
    else if (kp0_ - (qp0 + 31) < -64) { const int thr_ = qpos - 64 - kp0_ - 4 * hi;            \
        _Pragma("unroll") for (int r = 0; r < 16; ++r) { const int cr_ = (r & 3) + 8 * (r >> 2); p[r] = (cr_ >= thr_) ? p[r] : MB_NEG; } } \
    else if (kp0_ + 31 - qp0 > 64) { const int thr_ = qpos + 64 - kp0_ - 4 * hi;                 \
        _Pragma("unroll") for (int r = 0; r < 16; ++r) { const int cr_ = (r & 3) + 8 * (r >> 2); p[r] = (cr_ <= thr_) ? p[r] : MB_NEG; } } \
    if (!fixed) { \
        float mx_ = max3f(p[0], p[1], p[2]); \
        _Pragma("unroll") for (int r = 3; r < 15; r += 2) mx_ = max3f(mx_, p[r], p[r + 1]); \
        mx_ = fmaxf(mx_, p[15]); mx_ = fmaxf(mx_, __shfl_xor(mx_, 32)); \
        const bool need_ = (mx_ > -1e29f) && (setf == 0.f || mx_ > MB_THR); \
        if (__any(need_ ? 1 : 0)) { const float dlt_ = need_ ? mx_ : 0.f; const float alpha_ = (setf != 0.f) ? __builtin_amdgcn_exp2f(-dlt_) : 1.f; m_run += dlt_; setf = need_ ? 1.f : setf; \
            _Pragma("unroll") for (int r = 0; r < 16; ++r) { p[r] -= dlt_; negm[r] = -m_run; } \
            l_run *= alpha_; \
            _Pragma("unroll") for (int r = 0; r < 16; ++r) { const float a_ = __shfl(alpha_, crow(r, hi)); o[0][r] *= a_; o[1][r] *= a_; } } } \
    float s_ = 0.f; \
    _Pragma("unroll") for (int r = 0; r < 16; ++r) { p[r] = __builtin_amdgcn_exp2f(p[r]); s_ += p[r]; } \
    l_run += s_; \
    const u32x4 pw0_ = (u32x4){cvtpk_s(p[0], p[1]), cvtpk_s(p[2], p[3]), cvtpk_s(p[4], p[5]), cvtpk_s(p[6], p[7])}; \
    const u32x4 pw1_ = (u32x4){cvtpk_s(p[8], p[9]), cvtpk_s(p[10], p[11]), cvtpk_s(p[12], p[13]), cvtpk_s(p[14], p[15])}; \
    _Pragma("unroll") for (int i = 0; i < 4; ++i) { const int c_ = i * 64 + lane, key_ = c_ >> 3, piece_ = c_ & 7; \
        *(__attribute__((address_space(3))) u32x4*)((__attribute__((address_space(3))) char*)vt3 + (piece_ >> 2) * 2048 + key_ * 64 + (piece_ & 3) * 16) = VF[i]; } \
    asm volatile("s_waitcnt lgkmcnt(0)" ::: "memory"); \
    _Pragma("unroll") for (int dh = 0; dh < 2; ++dh) { \
        const s16x4 l0_ = vtr(vp0 + dh * 2048), h0_ = vtr(vp0 + dh * 2048 + 512), l1_ = vtr(vp0 + dh * 2048 + 1024), h1_ = vtr(vp0 + dh * 2048 + 1536); \
        const bf16x8 v0_ = (bf16x8){l0_[0], l0_[1], l0_[2], l0_[3], h0_[0], h0_[1], h0_[2], h0_[3]}, v1_ = (bf16x8){l1_[0], l1_[1], l1_[2], l1_[3], h1_[0], h1_[1], h1_[2], h1_[3]}; \
        o[dh] = __builtin_amdgcn_mfma_f32_32x32x16_bf16(__builtin_bit_cast(bf16x8, pw0_), v0_, o[dh], 0, 0, 0); \
        o[dh] = __builtin_amdgcn_mfma_f32_32x32x16_bf16(__builtin_bit_cast(bf16x8, pw1_), v1_, o[dh], 0, 0, 0); } \
    asm volatile("s_waitcnt lgkmcnt(0)" ::: "memory"); } while (0)

constexpr int MBL_ST = 32768, MBL_M = 512 * 64 * 2, MBL_L = MBL_M + 2048, MBL_BYTES = MBL_ST + MBL_L + 2048;
template <int P, int OP> __device__ __forceinline__ void mixb_item(const bf16* Qh, const bf16* Kh, const bf16* Vh, bf16* Oh, float* ssq0, char* blds, int tb, int lq0, int res, int dlsh, int mode, int nq, float kmax2, char* vt) {
    int lane_ = threadIdx.x & 63; asm volatile("" : "+v"(lane_));
    const int lane = lane_, r32 = lane & 31, hi = lane >> 5;
    const lds_cptr vt3 = (lds_cptr)vt; const lds_cptr vp0 = vt3 + ((lane >> 4) & 1) * 32 + (lane & 3) * 8 + (4 * hi + ((lane & 15) >> 2)) * 64;
    const int Lsub = SEQ >> dlsh;
    const int qp0 = (tb >> dlsh) + lq0, qpos = qp0 + (r32 & (nq - 1)), kstart = qp0 - 64;
    bf16x8 qr[4], kA[4], kB[4]; u32x4 vA[4], vB[4]; float qss = 0.f;
    #pragma unroll
    for (int d0 = 0; d0 < 4; ++d0) qr[d0] = *reinterpret_cast<const bf16x8*>(&Qh[(long)((qpos << dlsh) + res) * P + d0 * 16 + hi * 8]);
    MB_LOADK(kA, 0); MB_LOADV(vA, 0);
    #pragma unroll
    for (int d0 = 0; d0 < 4; ++d0) {
        #pragma unroll
        for (int j = 0; j < 8; ++j) { const float f = __uint_as_float((unsigned)(unsigned short)qr[d0][j] << 16); qss += f * f; } }
    qss += __shfl_xor(qss, 32);
    const float ref = sqrtf(qss * kmax2) * 1.03f + 0.25f;
    const bool fixed = !__any(ref > 40.0f ? 1 : 0);
    float m_run = fixed ? ref : 0.f, setf = fixed ? 1.f : 0.f, l_run = 0.f; f32x16 o[2]; o[0] = f32x16{}; o[1] = f32x16{}; f32x16 negm;
    #pragma unroll
    for (int r = 0; r < 16; ++r) negm[r] = -m_run;
    #pragma unroll 1
    for (int kt = 0; kt < 4; kt += 2) { MB_TILE(kA, kB, vA, vB, kt); MB_TILE(kB, kA, vB, vA, kt + 1); }
    MB_TILE(kA, kB, vA, vB, 4);
    l_run += __shfl_xor(l_run, 32);
    typedef __attribute__((address_space(3))) char* lds_ptr;
    const lds_ptr st = (lds_ptr)blds + MBL_ST;
    #define MB_LDSU16(p_) (*(__attribute__((address_space(3))) unsigned short*)(p_))
    #define MB_LDSF32(p_) (*(__attribute__((address_space(3))) float*)(p_))
    if (mode == 0) {
        #pragma unroll
        for (int r = 0; r < 16; ++r) { const int row = ((lq0 + crow(r, hi)) << dlsh) + res;
            MB_LDSU16(st + row * 128 + r32 * 2) = (unsigned short)cvtpk_s(o[0][r], 0.f); MB_LDSU16(st + row * 128 + 64 + r32 * 2) = (unsigned short)cvtpk_s(o[1][r], 0.f); }
        if (hi == 0) { const int row = ((lq0 + r32) << dlsh) + res; MB_LDSF32(st + MBL_M + row * 4) = m_run; MB_LDSF32(st + MBL_L + row * 4) = l_run; }
    } else {
        const int ri = ((lq0 + r32) << dlsh) + res;
        const float mP = MB_LDSF32(st + MBL_M + ri * 4), lP = MB_LDSF32(st + MBL_L + ri * 4);
        const float Mx = fmaxf(mP, m_run); float a = __builtin_amdgcn_exp2f(mP - Mx), b = __builtin_amdgcn_exp2f(m_run - Mx);
        const float lsum = a * lP + b * l_run;
        if (mode == 2) { const float inv = __builtin_amdgcn_rcpf(lsum); a *= inv; b *= inv; }
        const lds_ptr stg = (lds_ptr)vt;
        #pragma unroll
        for (int r = 0; r < 16; ++r) { const int q = crow(r, hi); const float aq = __shfl(a, q), bq = __shfl(b, q); const int row = ((lq0 + q) << dlsh) + res;
            const float op0 = __uint_as_float((unsigned)MB_LDSU16(st + row * 128 + r32 * 2) << 16), op1 = __uint_as_float((unsigned)MB_LDSU16(st + row * 128 + 64 + r32 * 2) << 16);
            const unsigned short w0 = (unsigned short)cvtpk_s(aq * op0 + bq * o[0][r], 0.f), w1 = (unsigned short)cvtpk_s(aq * op1 + bq * o[1][r], 0.f);
            if (mode == 2) { MB_LDSU16(stg + q * 128 + r32 * 2) = w0; MB_LDSU16(stg + q * 128 + 64 + r32 * 2) = w1; }
            else           { MB_LDSU16(st + row * 128 + r32 * 2) = w0; MB_LDSU16(st + row * 128 + 64 + r32 * 2) = w1; } }
        if (mode == 1) { if (hi == 0) { MB_LDSF32(st + MBL_M + ri * 4) = Mx; MB_LDSF32(st + MBL_L + ri * 4) = lsum; } }
        else {
            asm volatile("s_waitcnt lgkmcnt(0)" ::: "memory");
            #pragma unroll
            for (int i = 0; i < 4; ++i) { const int row = i * 8 + (lane >> 3), ch = lane & 7; const u32x4 v = *(const __attribute__((address_space(3))) u32x4*)(stg + row * 128 + ch * 16);
                const long tok = tb + ((lq0 + row) << dlsh) + res;
                *(u32x4*)(Oh + tok * OP + ch * 8) = v;
                float sq = 0.f;
                #pragma unroll
                for (int j = 0; j < 4; ++j) { const float a_ = __uint_as_float(v[j] << 16), b_ = __uint_as_float(v[j] & 0xffff0000u); sq += a_ * a_ + b_ * b_; }
                sq += __shfl_xor(sq, 1); sq += __shfl_xor(sq, 2); sq += __shfl_xor(sq, 4);
                if (ch == 0) atomicAdd(ssq0 + tok * 2, sq); }
            asm volatile("s_waitcnt lgkmcnt(0)" ::: "memory");
        }
    }
    #undef MB_LDSU16
    #undef MB_LDSF32
}
#undef SBAR
#undef WAIT_BAR
}

constexpr int NWAVES = 8;
constexpr int N_PHASES = 10;
constexpr int N_LAUNCHES = MK_N_LAUNCHES;
static_assert(N_LAUNCHES == 1 || N_LAUNCHES == N_PHASES, "MK_N_LAUNCHES is 1 or 10");

constexpr size_t MiB = 1u << 20;
constexpr size_t WS_CTL = 0, CTL_ZERO_BYTES = 1 * MiB;
constexpr size_t WS_ROPE = 1 * MiB;
constexpr size_t WS_WR = 5 * MiB;
constexpr size_t WS_WIN = 6 * MiB;
constexpr size_t WS_WOUT = 11 * MiB;
constexpr size_t WS_WGU = 13 * MiB;
constexpr size_t WS_WD = 77 * MiB;
constexpr size_t WS_LIST = 109 * MiB;
constexpr size_t WS_GATEV = 117 * MiB;
constexpr size_t WS_RSTD2 = 118 * MiB;
constexpr size_t WS_XN = 120 * MiB;
constexpr size_t WS_CAT = 248 * MiB;
constexpr size_t WS_PROJ = 376 * MiB;
constexpr size_t WS_KIMG = 664 * MiB;
constexpr size_t WS_VIMG = 680 * MiB;
constexpr size_t WS_MBQKV = 696 * MiB;
constexpr size_t WS_H = 888 * MiB;
constexpr size_t WS_HDN = 248 * MiB;
constexpr size_t WS_CON = 384 * MiB;
constexpr size_t WS_MIXS = 920 * MiB;
constexpr size_t WS_SRS = 990 * MiB;
constexpr size_t WS_SGATE = 998 * MiB;
constexpr size_t WS_END = 1006 * MiB;
static_assert(WS_HDN + (size_t)(2 * M + NEXP * 256) * DEXP * 2 <= WS_CON && WS_CON + (size_t)2 * M * DM * 2 <= WS_KIMG && WS_MBQKV + (size_t)3 * M * 512 * 2 <= WS_H && WS_H <= WS_MIXS, "d_ws map");
constexpr int CW_TMO = 0, CW_CODE = 1;
constexpr int CW_BAR = 4096;
constexpr int CW_CNT = 16384;
constexpr int CW_KMAX = 16448;
constexpr int CW_SSQ = 65536;

constexpr int RING_OFF = 0, RING_BYTES = 131072;
constexpr int LDSCTL_OFF = RING_BYTES, MISC_OFF = LDSCTL_OFF + 320;
constexpr int LDS_BYTES = 147456;
static_assert(MISC_OFF + 128 <= LDS_BYTES, "LDS map");

#define GAS __attribute__((address_space(1)))
#define LAS __attribute__((address_space(3)))
typedef unsigned short bf16;
typedef unsigned v4u __attribute__((ext_vector_type(4)));
typedef unsigned v2u __attribute__((ext_vector_type(2)));
typedef float f32x4 __attribute__((ext_vector_type(4)));
typedef short bf16x8 __attribute__((ext_vector_type(8)));
typedef GAS unsigned gu32;
#define RLX_AGENT __ATOMIC_RELAXED, __HIP_MEMORY_SCOPE_AGENT
#define LDS_WAIT() asm volatile("s_waitcnt lgkmcnt(0)" ::: "memory")
#define VM_WAIT() asm volatile("s_waitcnt vmcnt(0)" ::: "memory")
__device__ __forceinline__ unsigned f2bf(float f) { unsigned u = __builtin_bit_cast(unsigned, f); return (u + 0x7fffu + ((u >> 16) & 1u)) >> 16; }
__device__ __forceinline__ unsigned pk2(float lo, float hi) { return f2bf(lo) | (f2bf(hi) << 16); }
__device__ __forceinline__ float bflo(unsigned w) { return __builtin_bit_cast(float, w << 16); }
__device__ __forceinline__ float bfhi(unsigned w) { return __builtin_bit_cast(float, w & 0xffff0000u); }

#define XB_TMO      128
#define XB_XCNT(j)  (256  + 64 * (j))
#define XB_XSUB(j)  (1280 + 64 * (j))
#define XB_XGEN(j)  (2304 + 64 * (j))
#define XB_TOP      3328
#define XB_TOPGEN   3392
#define XCD_BAR_WORDS 3456
#define XB_SPIN_CAP (1u << 18)
__device__ __forceinline__ unsigned xb_ld(unsigned* p)              { return __hip_atomic_load(p, __ATOMIC_RELAXED, __HIP_MEMORY_SCOPE_AGENT); }
__device__ __forceinline__ unsigned xb_add(unsigned* p, unsigned v) { return __hip_atomic_fetch_add(p, v, __ATOMIC_RELAXED, __HIP_MEMORY_SCOPE_AGENT); }
__device__ __forceinline__ unsigned xb_xcc_id() { return (unsigned)__builtin_amdgcn_s_getreg((3 << 11) | 20) & 0xFu; }
#define XB_SPIN(cond, bar) do { unsigned _sp = 0; while (cond) { __builtin_amdgcn_s_sleep(1); \
    if ((++_sp & 255u) == 0u) { if (xb_ld(&(bar)[XB_TMO])) break; if (_sp > XB_SPIN_CAP) { atomicAdd(&(bar)[XB_TMO], 1u); break; } } } } while (0)
struct XcdBarrier { unsigned* bar; unsigned x; volatile LAS unsigned* st; };
__device__ __forceinline__ XcdBarrier xcd_barrier_post(unsigned* bar, volatile LAS unsigned* st) {
    XcdBarrier b; b.bar = bar; b.x = xb_xcc_id(); b.st = st;
    if (threadIdx.x == 0) (void)xb_add(&bar[XB_XCNT(b.x)], 1u);
    return b;
}
__device__ __forceinline__ void xcd_barrier_complete(unsigned* bar, unsigned x, unsigned& nloc, unsigned& nx) {
    const unsigned G = gridDim.x * gridDim.y * gridDim.z;
    unsigned sum, cnt, mine, sp = 0u;
    for (;;) {
        sum = 0u; cnt = 0u; mine = 0u;
#pragma unroll
        for (unsigned j = 0; j < 16; ++j) { const unsigned c = xb_ld(&bar[XB_XCNT(j)]); sum += c; cnt += (c > 0u) ? 1u : 0u; mine = (j == x) ? c : mine; }
        if (sum == G) break;
        __builtin_amdgcn_s_sleep(1);
        if ((++sp & 255u) == 0u) { if (xb_ld(&bar[XB_TMO])) break; if (sp > XB_SPIN_CAP) { atomicAdd(&bar[XB_TMO], 1u); break; } }
    }
    nloc = mine > 0u ? mine : 1u; nx = cnt > 0u ? cnt : 1u;
}
__device__ __forceinline__ void xcd_barrier(const XcdBarrier& b) {
    asm volatile("s_waitcnt vmcnt(0)" ::: "memory");
    __syncthreads();
    if (threadIdx.x == 0) {
        unsigned* bar = b.bar;
        __builtin_amdgcn_s_waitcnt(0);
        unsigned nloc = b.st[0], nx = b.st[1];
        if (nloc == 0u) { xcd_barrier_complete(bar, b.x, nloc, nx); b.st[0] = nloc; b.st[1] = nx; }
        const unsigned old = xb_add(&bar[XB_XSUB(b.x)], 1u);
        const unsigned gen = old / nloc;
        if (old + 1u == (gen + 1u) * nloc) {
            __builtin_amdgcn_fence(__ATOMIC_RELEASE, "agent");
            asm volatile("s_waitcnt vmcnt(0)" ::: "memory");
            const unsigned og = xb_add(&bar[XB_TOP], 1u);
            const unsigned tg = og / nx;
            if (og + 1u == (tg + 1u) * nx) xb_add(&bar[XB_TOPGEN], 1u);
            else XB_SPIN(xb_ld(&bar[XB_TOPGEN]) == tg, bar);
            __builtin_amdgcn_fence(__ATOMIC_ACQUIRE, "agent");
            xb_add(&bar[XB_XGEN(b.x)], 1u);
            asm volatile("s_waitcnt vmcnt(0)" ::: "memory");
        } else {
            XB_SPIN(xb_ld(&bar[XB_XGEN(b.x)]) == gen, bar);
            __builtin_amdgcn_fence(__ATOMIC_ACQUIRE, "agent");
            asm volatile("s_waitcnt vmcnt(0)" ::: "memory");
        }
    }
    __syncthreads();
}

struct Frame {
    LAS unsigned char* lds;
    volatile LAS unsigned* MISC;
    gu32* ctl;
    int tid, lane, wave;
    int vcu, G;
    const float *x, *n1g, *w_in, *qng, *kng, *onga, *ongb, *w_out, *n2g, *rgw, *rgb, *rew, *reb, *wg, *wu, *wd, *fng; float* out;
    unsigned char* ws;
};
__device__ __forceinline__ float wave_sum(float v) {
#pragma unroll
    for (int o = 1; o < 64; o <<= 1) v += __shfl_xor(v, o);
    return v;
}
template <class F> __device__ __forceinline__ void tr_item(const F& f, int K, bf16* WT0  , int k0, LAS float* scr, int lane) {
#pragma unroll 8
    for (int i = 0; i < 32; ++i) { const int kk = 2 * i + (lane >> 5); scr[kk * 33 + (lane & 31)] = f.load(k0 + kk, lane & 31); }
    LDS_WAIT(); asm volatile("" ::: "memory");
    const int c = lane & 7;
#pragma unroll
    for (int j = 0; j < 4; ++j) { const int n = (lane >> 3) + 8 * j; const LAS float* s = scr + (8 * c) * 33 + n;
        v4u o; o.x = pk2(s[0 * 33], s[1 * 33]); o.y = pk2(s[2 * 33], s[3 * 33]); o.z = pk2(s[4 * 33], s[5 * 33]); o.w = pk2(s[6 * 33], s[7 * 33]);
        *(GAS v4u*)(WT0 + (size_t)n * K + k0 + 8 * c) = o; }
    LDS_WAIT(); asm volatile("" ::: "memory");
}
struct LdPlain { const float* W; int N, n0; __device__ __forceinline__ float load(int k, int n) const { return W[(size_t)k * N + n0 + n]; } };
struct LdPlainG2 { const float* W; int N, n0; const float* ga; const float* gb;
    __device__ __forceinline__ float load(int k, int n) const { return W[(size_t)k * N + n0 + n] * (k < 512 ? ga[k] : gb[k - 512]); } };
struct LdRope256 { const float* W; int N, n0;
    __device__ __forceinline__ float load(int k, int n) const { const int nd = n0 + n; return W[(size_t)k * N + (nd & ~255) + pg8::ropemap256(nd & 255)]; } };
struct LdGateUp { const float* Wg; const float* Wu; const float* g2; int j0;
    __device__ __forceinline__ float load(int k, int n) const { const unsigned long long pa = (unsigned long long)Wg, pb = (unsigned long long)Wu; const bool isg = ((n >> 2) & 1) == 0;
        const unsigned lo = isg ? (unsigned)pa : (unsigned)pb, hi = isg ? (unsigned)(pa >> 32) : (unsigned)(pb >> 32);
        const float* Wm = (const float*)(((unsigned long long)hi << 32) | lo); return Wm[(size_t)k * DEXP + j0 + (n >> 3) * 8 + (n & 3)] * g2[k]; } };

__device__ __forceinline__ void p0_prologue(Frame& F) {
    LAS float* scr = (LAS float*)(F.lds + RING_OFF + F.wave * 16384);
    const int gw = F.vcu * NWAVES + F.wave, NGW = F.G * NWAVES;
    bf16* Win_t = (bf16*)(F.ws + WS_WIN); bf16* Wout_t = (bf16*)(F.ws + WS_WOUT); bf16* Wgu_t = (bf16*)(F.ws + WS_WGU); bf16* Wd_t = (bf16*)(F.ws + WS_WD); bf16* Wr_t = (bf16*)(F.ws + WS_WR);
    constexpr int I_IN = (DM / 64) * (NPROJ / 32), I_OUT = (DM / 64) * (DM / 32), I_GU1 = (DM / 64) * (1024 / 32), I_D1 = (DEXP / 64) * (DM / 32);
    constexpr int NITEMS = I_IN + I_OUT + NEXP * I_GU1 + NEXP * I_D1;
    for (int it = gw; it < NITEMS; it += NGW) {
        int r = it;
        if (r < I_IN) { const int nblk = NPROJ / 32, kb = r / nblk, nb = r % nblk; LdRope256 f{F.w_in, NPROJ, 32 * nb}; tr_item(f, DM, Win_t + (size_t)(32 * nb) * DM, 64 * kb, scr, F.lane); continue; } r -= I_IN;
        if (r < I_OUT) { const int nblk = DM / 32, kb = r / nblk, nb = r % nblk; LdPlainG2 f{F.w_out, DM, 32 * nb, F.onga, F.ongb}; tr_item(f, DM, Wout_t + (size_t)(32 * nb) * DM, 64 * kb, scr, F.lane); continue; } r -= I_OUT;
        if (r < NEXP * I_GU1) { const int e = r / I_GU1, q = r % I_GU1, kb = q / 32, nb = q % 32;
            LdGateUp f{F.wg + (size_t)e * DM * DEXP, F.wu + (size_t)e * DM * DEXP, F.n2g, 128 * (nb >> 3) + 32 * (nb & 3) + 4 * ((nb >> 2) & 1)}; tr_item(f, DM, Wgu_t + ((size_t)e * 1024 + 32 * nb) * DM, 64 * kb, scr, F.lane); continue; } r -= NEXP * I_GU1;
        { const int e = r / I_D1, q = r % I_D1, nblk = DM / 32, kb = q / nblk, nb = q % nblk; LdPlain f{F.wd + (size_t)e * DEXP * DM, DM, 32 * nb}; tr_item(f, DEXP, Wd_t + ((size_t)e * DM + 32 * nb) * DEXP, 64 * kb, scr, F.lane); }
    }
    for (int idx = gw * 64 + F.lane; idx < 48 * DM; idx += NGW * 64) { const int c = idx >> 10, k = idx & 1023;
        float v = 0.f; if (c < 4) v = F.rgw[k * 4 + c]; else if (c < 36) v = F.rew[k * 32 + (c - 4)];
        Wr_t[idx] = (bf16)f2bf(v * F.n2g[k]); }
    { float* cosA = (float*)(F.ws + WS_ROPE); float* sinA = cosA + SEQ * 32; float* cosB = sinA + SEQ * 32; float* sinB = cosB + SEQ * 32;
      const int j = F.lane & 31, ja = j & 15;
      const double l2b = 13.287712379549449, i2pi = 0.15915494309189535;
      const double cB = exp2(-(double)(2 * j) * (1.0 / 64.0) * l2b) * i2pi, cA = exp2(-(double)(2 * ja) * (1.0 / 32.0) * l2b) * i2pi;
      for (int idx = gw * 64 + F.lane; idx < SEQ * 32; idx += NGW * 64) { const int t = idx >> 5;
          double pB = (double)t * cB; pB -= floor(pB); const float rB = (float)pB;
          cosB[idx] = __builtin_amdgcn_cosf(rB); sinB[idx] = __builtin_amdgcn_sinf(rB);
          const int pos = (j < 16) ? (t >> 6) : (t & 63);
          double pA = (double)pos * cA; pA -= floor(pA); const float rA = (float)pA;
          cosA[idx] = __builtin_amdgcn_cosf(rA); sinA[idx] = __builtin_amdgcn_sinf(rA); } }
    { bf16* XN = (bf16*)(F.ws + WS_XN);
      f32x4 gv[4];
#pragma unroll
      for (int j = 0; j < 4; ++j) gv[j] = *((const GAS f32x4*)F.n1g + F.lane + 64 * j);
      for (int m = gw; m < M; m += NGW) { const GAS f32x4* xr = (const GAS f32x4*)(F.x + (size_t)m * DM) + F.lane;
          f32x4 v[4]; float s = 0.f;
#pragma unroll
          for (int j = 0; j < 4; ++j) { v[j] = xr[64 * j]; s += (v[j].x * v[j].x + v[j].y * v[j].y) + (v[j].z * v[j].z + v[j].w * v[j].w); }
          const float rstd = 1.f / sqrtf(wave_sum(s) * (1.f / DM) + EPS);
          GAS unsigned long long* o8 = (GAS unsigned long long*)(XN + (size_t)m * DM) + F.lane;
#pragma unroll
          for (int j = 0; j < 4; ++j) o8[64 * j] = (unsigned long long)pk2(v[j].x * rstd * gv[j].x, v[j].y * rstd * gv[j].y) | ((unsigned long long)pk2(v[j].z * rstd * gv[j].z, v[j].w * rstd * gv[j].w) << 32); } }
}

__device__ __forceinline__ void p6_router(Frame& F) {
    const bf16* HB = (const bf16*)(F.ws + WS_XN); const bf16* Wr_t = (const bf16*)(F.ws + WS_WR);
    int* list = (int*)(F.ws + WS_LIST); float* srs = (float*)(F.ws + WS_SRS); float* sgate = (float*)(F.ws + WS_SGATE);
    LAS float* lg = (LAS float*)(F.lds + RING_OFF) + F.wave * (32 * 48);
    LAS int* lcnt = (LAS int*)(F.lds + RING_OFF + 65536);
    const int lane = F.lane, fr = lane & 15, fq = lane >> 4;
    for (int ch = F.vcu; ch < M / 256; ch += F.G) {
        if (F.tid < 64) lcnt[F.tid] = 0;
        __syncthreads();
        const int tok0 = ch * 256 + F.wave * 32;
        f32x4 acc[2][3];
#pragma unroll
        for (int a = 0; a < 2; ++a)
#pragma unroll
            for (int b = 0; b < 3; ++b) acc[a][b] = (f32x4){0.f, 0.f, 0.f, 0.f};
        float ss0 = 0.f, ss1 = 0.f;
        const bf16* a0p = HB + (size_t)(tok0 + fr) * DM + 8 * fq; const bf16* a1p = a0p + (size_t)16 * DM;
        const bf16* bp = Wr_t + (size_t)fr * DM + 8 * fq;
#pragma unroll 8
        for (int ks = 0; ks < DM / 32; ++ks) {
            const bf16x8 a0 = *(const bf16x8*)(a0p + ks * 32), a1 = *(const bf16x8*)(a1p + ks * 32);
            const bf16x8 b0 = *(const bf16x8*)(bp + ks * 32), b1 = *(const bf16x8*)(bp + (size_t)16 * DM + ks * 32), b2 = *(const bf16x8*)(bp + (size_t)32 * DM + ks * 32);
#pragma unroll
            for (int j = 0; j < 8; ++j) { const float f0 = __builtin_bit_cast(float, (unsigned)(unsigned short)a0[j] << 16), f1 = __builtin_bit_cast(float, (unsigned)(unsigned short)a1[j] << 16); ss0 += f0 * f0; ss1 += f1 * f1; }
            acc[0][0] = __builtin_amdgcn_mfma_f32_16x16x32_bf16(a0, b0, acc[0][0], 0, 0, 0); acc[0][1] = __builtin_amdgcn_mfma_f32_16x16x32_bf16(a0, b1, acc[0][1], 0, 0, 0); acc[0][2] = __builtin_amdgcn_mfma_f32_16x16x32_bf16(a0, b2, acc[0][2], 0, 0, 0);
            acc[1][0] = __builtin_amdgcn_mfma_f32_16x16x32_bf16(a1, b0, acc[1][0], 0, 0, 0); acc[1][1] = __builtin_amdgcn_mfma_f32_16x16x32_bf16(a1, b1, acc[1][1], 0, 0, 0); acc[1][2] = __builtin_amdgcn_mfma_f32_16x16x32_bf16(a1, b2, acc[1][2], 0, 0, 0);
        }
        ss0 += __shfl_xor(ss0, 16); ss0 += __shfl_xor(ss0, 32); ss1 += __shfl_xor(ss1, 16); ss1 += __shfl_xor(ss1, 32);
#pragma unroll
        for (int a = 0; a < 2; ++a)
#pragma unroll
            for (int b = 0; b < 3; ++b)
#pragma unroll
                for (int j = 0; j < 4; ++j) lg[(a * 16 + 4 * fq + j) * 48 + b * 16 + fr] = acc[a][b][j];
        LDS_WAIT(); asm volatile("" ::: "memory");
        int e1 = 0, e2 = 0, pos1 = 0, pos2 = 0; float gt1 = 0.f, gt2 = 0.f, rs = 0.f;
        if (lane < 32) {
            rs = 1.f / sqrtf(((lane < 16) ? ss0 : ss1) * (1.f / DM) + EPS);
            const LAS float* L = lg + lane * 48;
            float g[4]; float gmax = -INFINITY; int gi = 0;
#pragma unroll
            for (int c = 0; c < 4; ++c) { g[c] = L[c] * rs + F.rgb[c]; if (g[c] > gmax) { gmax = g[c]; gi = c; } }
            float gs = 0.f;
#pragma unroll
            for (int c = 0; c < 4; ++c) gs += __expf(g[c] - gmax);
            const float gp = 1.0f / gs;
            float l1 = -INFINITY, l2 = -INFINITY; int i1 = 0, i2 = 0;
#pragma unroll
            for (int j = 0; j < 8; ++j) { const float v = L[4 + gi * 8 + j] * rs + F.reb[gi * 8 + j];
                if (v > l1) { l2 = l1; i2 = i1; l1 = v; i1 = j; } else if (v > l2) { l2 = v; i2 = j; } }
            const float p1 = 1.0f / (1.0f + __expf(l2 - l1));
            e1 = gi * 8 + i1; e2 = gi * 8 + i2; gt1 = gp * p1; gt2 = gp * (1.0f - p1);
            pos1 = atomicAdd((int*)&lcnt[e1], 1); pos2 = atomicAdd((int*)&lcnt[e2], 1);
        }
        __syncthreads();
        if (F.tid < 32) lcnt[32 + F.tid] = (int)atomicAdd((unsigned*)(F.ctl + CW_CNT + F.tid), (unsigned)lcnt[F.tid]);
        __syncthreads();
        if (lane < 32) { const int tok = tok0 + lane;
            const int i1 = e1 * LISTCAP + lcnt[32 + e1] + pos1, i2 = e2 * LISTCAP + lcnt[32 + e2] + pos2;
            list[i1] = tok * 2; list[i2] = tok * 2 + 1; srs[i1] = rs; srs[i2] = rs; sgate[i1] = gt1; sgate[i2] = gt2; }
        __syncthreads();
    }
}
__device__ __forceinline__ void moe_table(Frame& F) {
    LAS int* tst = (LAS int*)(F.lds + LDSCTL_OFF);
    if (F.tid < 64) {
        const int c = (F.lane < 32) ? (int)__hip_atomic_load(F.ctl + CW_CNT + F.lane, RLX_AGENT) : 0;
        int nt = (c + 255) >> 8, inc = nt;
#pragma unroll
        for (int o = 1; o < 32; o <<= 1) { const int v = __shfl_up(inc, o); if (F.lane >= o) inc += v; }
        if (F.lane < 32) { tst[F.lane] = inc - nt; tst[33 + F.lane] = c; if (F.lane == 31) tst[32] = inc; }
    }
    __syncthreads();
}
__device__ __forceinline__ void p9_final(Frame& F) {
    const bf16* HB = (const bf16*)(F.ws + WS_XN); const bf16* CON = (const bf16*)(F.ws + WS_CON);
    const int gw = F.vcu * NWAVES + F.wave, NGW = F.G * NWAVES;
    f32x4 gv[4];
#pragma unroll
    for (int j = 0; j < 4; ++j) gv[j] = *((const GAS f32x4*)F.fng + F.lane + 64 * j);
    for (int m = gw; m < M; m += NGW) {
        const GAS v2u* hr = (const GAS v2u*)(HB + (size_t)m * DM) + F.lane;
        const GAS v2u* c0 = (const GAS v2u*)(CON + (size_t)(2 * m) * DM) + F.lane; const GAS v2u* c1 = (const GAS v2u*)(CON + (size_t)(2 * m + 1) * DM) + F.lane;
        f32x4 v[4]; float s = 0.f;
#pragma unroll
        for (int j = 0; j < 4; ++j) { const v2u h = hr[64 * j]; const v2u a = c0[64 * j], b = c1[64 * j];
            v[j].x = bflo(h.x) + (bflo(a.x) + bflo(b.x)); v[j].y = bfhi(h.x) + (bfhi(a.x) + bfhi(b.x)); v[j].z = bflo(h.y) + (bflo(a.y) + bflo(b.y)); v[j].w = bfhi(h.y) + (bfhi(a.y) + bfhi(b.y));
            s += (v[j].x * v[j].x + v[j].y * v[j].y) + (v[j].z * v[j].z + v[j].w * v[j].w); }
        const float rstd = 1.f / sqrtf(wave_sum(s) * (1.f / DM) + EPS);
        GAS f32x4* o = (GAS f32x4*)(F.out + (size_t)m * DM) + F.lane;
#pragma unroll
        for (int j = 0; j < 4; ++j) o[64 * j] = v[j] * rstd * gv[j];
    }
}

struct Args { const float* in[17]; float* out; unsigned char* ws; int ph_lo, ph_hi; };
__global__ void __launch_bounds__(NWAVES * 64, 2) skel_fwd(Args args) {
    extern __shared__ __attribute__((aligned(16))) unsigned char lds[];
    Frame F;
    F.lds = (LAS unsigned char*)lds;
    F.MISC = (volatile LAS unsigned*)(F.lds + MISC_OFF);
    F.tid = threadIdx.x; F.lane = F.tid & 63; F.wave = __builtin_amdgcn_readfirstlane(F.tid >> 6);
    F.G = gridDim.x; { const int bx = blockIdx.x; F.vcu = (F.G % 8 == 0) ? (bx % 8) * (F.G / 8) + bx / 8 : bx; }
    unsigned char* ws = args.ws; F.ws = ws;
    F.ctl = (gu32*)(ws + WS_CTL);
    F.x = args.in[0]; F.n1g = args.in[1]; F.w_in = args.in[2]; F.qng = args.in[3]; F.kng = args.in[4]; F.onga = args.in[5]; F.ongb = args.in[6]; F.w_out = args.in[7]; F.n2g = args.in[8];
    F.rgw = args.in[9]; F.rgb = args.in[10]; F.rew = args.in[11]; F.reb = args.in[12]; F.wg = args.in[13]; F.wu = args.in[14]; F.wd = args.in[15]; F.fng = args.in[16]; F.out = args.out;
    for (int u = F.tid; u < (LDS_BYTES - LDSCTL_OFF) / 4; u += NWAVES * 64) ((LAS unsigned*)(F.lds + LDSCTL_OFF))[u] = 0u;
    __syncthreads();
    XcdBarrier bar; bar.bar = (unsigned*)(F.ctl + CW_BAR); bar.x = 0; bar.st = nullptr;
    if (N_LAUNCHES == 1) bar = xcd_barrier_post((unsigned*)(F.ctl + CW_BAR), F.MISC + 8);
#define GRID_BAR() do { if (N_LAUNCHES == 1) xcd_barrier(bar); } while (0)
    const int lo = args.ph_lo, hi = args.ph_hi;
#define IN(k) (lo <= (k) && (k) < hi)
#define BOTH(k) (IN(k) && IN((k) + 1))
    bf16* XN = (bf16*)(ws + WS_XN); bf16* PROJ = (bf16*)(ws + WS_PROJ); bf16* CAT = (bf16*)(ws + WS_CAT);

    if (IN(0)) { p0_prologue(F); if (PROBE_DUP & 1) { GRID_BAR(); p0_prologue(F); } if (BOTH(0)) GRID_BAR(); }

    if (IN(1)) {
        pg8::Gemm g{XN, (const bf16*)(ws + WS_WIN), M, NPROJ, DM}; pg8::StaticOrder S; S.init(M, NPROJ, F.G, (int)blockIdx.x);
        const float* cosA = (const float*)(ws + WS_ROPE); const float* sinA = cosA + SEQ * 32; const float* cosB = sinA + SEQ * 32; const float* sinB = cosB + SEQ * 32;
        pg8::EpiProj E{PROJ, NPROJ, cosA, sinA, cosB, sinB, F.qng, F.kng, SEQ - 1, EPS, C2, (unsigned*)(F.ctl + CW_KMAX), 13, ws + WS_KIMG, ws + WS_VIMG, (bf16*)(ws + WS_MBQKV)};
        pg8::gemm_phase<pg8::EpiProj, pg8::StaticOrder, true>(F.lds + RING_OFF, g, S, E);
        if (PROBE_DUP & 2) { GRID_BAR(); pg8::gemm_phase<pg8::EpiProj, pg8::StaticOrder, true>(F.lds + RING_OFF, g, S, E); }
        if (IN(1) && IN(3)) GRID_BAR();
    }

    if (IN(3)) {
        using abf = attn_body::bf16;
        float* ssq = (float*)(F.ctl + CW_SSQ);
        float sref; { float gq = fabsf(F.qng[F.lane]), gk = fabsf(F.kng[F.lane]);
#pragma unroll
            for (int o_ = 1; o_ < 64; o_ <<= 1) { gq = fmaxf(gq, __shfl_xor(gq, o_)); gk = fmaxf(gk, __shfl_xor(gk, o_)); }
            sref = 64.0f * gq * gk * C2 * 1.03f + 0.25f; }
        const bool fixref = __builtin_amdgcn_readfirstlane(sref <= 40.0f ? 1 : 0) != 0;
        for (int rep = 0; rep < ((PROBE_DUP & 64) ? 2 : 1); ++rep)
        for (int i = 0;; ++i) {
            const int L = i * F.G + F.vcu; if (L >= BATCH * 8 * (SEQ / 256)) break;
            const int qb = L & 31, h = (L >> 5) & 7, b = L >> 8;
            const abf* Qw0 = (const abf*)PROJ + ((size_t)b * SEQ + (size_t)qb * 256) * NPROJ + h * 64;
            const abf* Kh = (const abf*)(ws + WS_KIMG) + (size_t)(b * 2 + (h >> 2)) * 128 * 4096;
            const abf* Vh = (const abf*)(ws + WS_VIMG) + (size_t)(b * 2 + (h >> 2)) * 128 * 4096;
            abf* Ow0 = (abf*)CAT + ((size_t)b * SEQ + (size_t)qb * 256) * DM + h * 64;
            attn_body::attn_unit<8, NPROJ, 0, 0, DM>(Qw0, Kh, Vh, Ow0, ssq + ((size_t)b * SEQ + (size_t)qb * 256) * 2, fixref, sref, SEQ / 64, (char*)lds + RING_OFF);
        }
        __syncthreads();
        { char* bl = (char*)lds + RING_OFF; char* vt = bl + F.wave * 4096;
          static_assert(attn_body::MBL_BYTES <= RING_BYTES, "mixer B LDS map");
          const unsigned* kmaxw = (const unsigned*)(F.ctl + CW_KMAX);
          for (int rep = 0; rep < ((PROBE_DUP & 4) ? 2 : 1); ++rep)
          for (int U = F.vcu; U < BATCH * 8 * 16; U += F.G) {
            const int blk = U & 15, h = (U >> 4) & 7, b = U >> 7, tb = blk * 512;
            const abf* base = (const abf*)(ws + WS_MBQKV) + (size_t)(b * 8 + h) * SEQ * 64;
            const abf* Qh = base; const abf* Kh = base + (size_t)64 * SEQ * 64; const abf* Vh = base + (size_t)128 * SEQ * 64;
            abf* Oh = (abf*)CAT + (size_t)b * SEQ * DM + 512 + h * 64; float* ssqb = (rep == 0) ? ssq + (size_t)b * SEQ * 2 + 1 : (float*)(ws + WS_GATEV);
            const float kmax2 = __uint_as_float(kmaxw[b * 8 + h]);
            #pragma unroll 1
            for (int it = 0; it < 6; ++it) {
                const int j = F.wave + 8 * (it & 1), mode = it >> 1, dlsh = 2 * mode;
                const int lq0 = (mode == 0) ? 32 * j : (mode == 1) ? 32 * (j >> 2) : 0, res = (mode == 0) ? 0 : (mode == 1) ? (j & 3) : j;
                attn_body::mixb_item<64, DM>(Qh, Kh, Vh, Oh, ssqb, bl, tb, lq0, res, dlsh, mode, 32, kmax2, vt);
                if (it & 1) __syncthreads();
            }
          } }
        if (IN(3) && IN(5)) GRID_BAR();
    }

    if (IN(5)) {
        pg8::Gemm g{CAT, (const bf16*)(ws + WS_WOUT), M, DM, DM}; pg8::StaticOrder S; S.init(M, DM, F.G, (int)blockIdx.x);
        pg8::EpiH E{F.x, XN, DM, (const float*)(F.ctl + CW_SSQ), (LAS float*)(F.lds + LDSCTL_OFF + 512), EPS};
        pg8::gemm_phase<pg8::EpiH, pg8::StaticOrder, true>(F.lds + RING_OFF, g, S, E);
        if (PROBE_DUP & 8) { GRID_BAR(); pg8::gemm_phase<pg8::EpiH, pg8::StaticOrder, true>(F.lds + RING_OFF, g, S, E); }
        if (BOTH(5)) GRID_BAR();
    }
    if (IN(6)) { p6_router(F); if (BOTH(6)) GRID_BAR(); }

    if (IN(7)) {
        moe_table(F);
        pg8::Gemm g{XN, (const bf16*)(ws + WS_WGU), 0, 1024, DM};
        pg8::MoeOrder<true> S{F.G, F.vcu, (const LAS int*)(F.lds + LDSCTL_OFF), (const int*)(ws + WS_LIST), (LAS int*)(F.lds + LDSCTL_OFF + 4608), (const float*)(ws + WS_SRS), (LAS float*)(F.lds + LDSCTL_OFF + 7680)};
        pg8::EpiGU E{(bf16*)(ws + WS_HDN), (const LAS float*)(F.lds + LDSCTL_OFF + 7680)};
        pg8::gemm_phase<pg8::EpiGU, pg8::MoeOrder<true>, true>(F.lds + RING_OFF, g, S, E);
        if (PROBE_DUP & 16) { GRID_BAR(); pg8::gemm_phase<pg8::EpiGU, pg8::MoeOrder<true>, true>(F.lds + RING_OFF, g, S, E); }
        if (BOTH(7)) GRID_BAR();
    }
    if (IN(8)) {
        moe_table(F);
        pg8::Gemm g{(const bf16*)(ws + WS_HDN), (const bf16*)(ws + WS_WD), 0, DM, DEXP};
        pg8::MoeOrder<false> S{F.G, F.vcu, (const LAS int*)(F.lds + LDSCTL_OFF), (const int*)(ws + WS_LIST), (LAS int*)(F.lds + LDSCTL_OFF + 4608), (const float*)(ws + WS_SGATE), (LAS float*)(F.lds + LDSCTL_OFF + 7680)};
        pg8::EpiDown E{(bf16*)(ws + WS_CON), (const LAS int*)(F.lds + LDSCTL_OFF + 4608), (const LAS float*)(F.lds + LDSCTL_OFF + 7680)};
        pg8::gemm_phase<pg8::EpiDown, pg8::MoeOrder<false>, true>(F.lds + RING_OFF, g, S, E);
        if (PROBE_DUP & 128) { GRID_BAR(); pg8::gemm_phase<pg8::EpiDown, pg8::MoeOrder<false>, true>(F.lds + RING_OFF, g, S, E); }
        if (BOTH(8)) GRID_BAR();
    }
    if (IN(9)) { p9_final(F); if (PROBE_DUP & 32) { GRID_BAR(); p9_final(F); } }
#undef IN
#undef BOTH
}

extern "C" void kernel_launch(void* const* d_in, const int* in_sizes, int n_in, void* d_out, int out_size, void* d_ws, size_t ws_size, hipStream_t stream) {
    static int grid = 0;
    if (grid == 0) {
        if (n_in != 17 || in_sizes[0] != M * DM || out_size != M * DM || ws_size < WS_END) { fprintf(stderr, "kernel_launch: unexpected shapes (n_in %d, in0 %d, out %d, ws %zu)\n", n_in, n_in > 0 ? in_sizes[0] : -1, out_size, ws_size); grid = -1; return; }
        int dev = 0, cus = 0, per_cu = 0;
        if (hipGetDevice(&dev) != hipSuccess || hipDeviceGetAttribute(&cus, hipDeviceAttributeMultiprocessorCount, dev) != hipSuccess) { grid = -1; return; }
        if (hipFuncSetAttribute((const void*)skel_fwd, hipFuncAttributeMaxDynamicSharedMemorySize, LDS_BYTES) != hipSuccess) { fprintf(stderr, "kernel_launch: hipFuncSetAttribute failed\n"); grid = -1; return; }
        if (hipOccupancyMaxActiveBlocksPerMultiprocessor(&per_cu, (const void*)skel_fwd, NWAVES * 64, LDS_BYTES) != hipSuccess || per_cu < 1)
            fprintf(stderr, "kernel_launch: note: occupancy query reports %d workgroups per CU\n", per_cu);
        (void)hipGetLastError();
        grid = cus;
    }
    if (grid < 0) return;
    if (hipMemsetAsync((char*)d_ws + WS_CTL, 0, CTL_ZERO_BYTES, stream) != hipSuccess) return;
    Args a{};
    for (int i = 0; i < 17; ++i) a.in[i] = (const float*)d_in[i];
    a.out = (float*)d_out; a.ws = (unsigned char*)d_ws;
    if (N_LAUNCHES == 1) { a.ph_lo = 0; a.ph_hi = N_PHASES; hipLaunchKernelGGL(skel_fwd, dim3(grid), dim3(NWAVES * 64), LDS_BYTES, stream, a); }
    else for (int li = 0; li < N_PHASES; ++li) { a.ph_lo = li; a.ph_hi = li + 1; hipLaunchKernelGGL(skel_fwd, dim3(grid), dim3(NWAVES * 64), LDS_BYTES, stream, a); }
}
```
